# Optimizing an MI355X kernel written in HIP

```python
import math
import jax, jax.numpy as jnp
from jax import lax
import numpy as np

D_MODEL = 1024
BATCH = 32
SEQ = 2048
DEPTH = 1

N_META = 16
NORM_EPS = 1e-6
HG_HEADS = 8
HG_DK = D_MODEL // HG_HEADS
HG_DV = D_MODEL // HG_HEADS
HG_WIDTH = HG_HEADS * HG_DK
HG_CHUNK = 16
MLA_HEADS = 8
QK_NOPE = 128
QK_ROPE = 64
V_HEAD = 128
Q_LORA = 256
KV_LORA = 256
ROPE_THETA = 10000.0
ATTN_BLOCK = 128
FFN_HIDDEN = ((8 * D_MODEL + 3 * 256 - 1) // (3 * 256)) * 256
IN_SIZES = (HG_WIDTH, HG_WIDTH, HG_WIDTH, HG_WIDTH,
            Q_LORA, KV_LORA, QK_ROPE,
            D_MODEL, D_MODEL)
IN_COLS = sum(IN_SIZES)

kernel_name = "hybrid_hgrn2_mla_gated_block"


def rms_norm(x, g):
    xf = x.astype(jnp.float32)
    y = xf * lax.rsqrt(jnp.mean(xf * xf, axis=-1, keepdims=True) + NORM_EPS)
    return (y * g.astype(jnp.float32)).astype(x.dtype)


def rope_tables(length):
    pos = jnp.arange(length, dtype=jnp.float32)
    inv_freq = 1.0 / (ROPE_THETA ** (jnp.arange(0, QK_ROPE, 2, dtype=jnp.float32) / QK_ROPE))
    ang = pos[:, None] * inv_freq[None, :]
    return jnp.cos(ang), jnp.sin(ang)


def apply_rope(t, cos, sin):
    t32 = t.astype(jnp.float32)
    t1, t2 = jnp.split(t32, 2, axis=-1)
    return jnp.concatenate([t1 * cos - t2 * sin, t2 * cos + t1 * sin], axis=-1).astype(t.dtype)


def hgrn2_chunk_scan(q, k, v, logf):
    B, L, H, _ = q.shape
    n = L // HG_CHUNK

    def to_chunks(t):
        return t.reshape(B, n, HG_CHUNK, H, t.shape[-1]).transpose(1, 0, 3, 2, 4)

    xs = (to_chunks(q), to_chunks(k), to_chunks(v), to_chunks(logf))
    causal = jnp.tril(jnp.ones((HG_CHUNK, HG_CHUNK), dtype=bool))[:, :, None]

    def step(S, inp):
        qb, kb, vb, gb = inp
        b = jnp.cumsum(gb, axis=2)
        o_inter = jnp.einsum('bhtk,bhkv->bhtv', qb * jnp.exp(b), S)
        diff = b[:, :, :, None, :] - b[:, :, None, :, :]
        decay = jnp.exp(jnp.where(causal, diff, -jnp.inf))
        A = jnp.einsum('bhtsk,bhsk->bhts', decay * qb[:, :, :, None, :], kb)
        o_intra = jnp.einsum('bhts,bhsv->bhtv', A, vb)
        b_last = b[:, :, -1:, :]
        S_new = jnp.exp(b_last[:, :, 0, :])[..., None] * S + jnp.einsum(
            'bhsk,bhsv->bhkv', kb * jnp.exp(b_last - b), vb)
        return S_new, o_inter + o_intra

    S0 = jnp.zeros((B, H, q.shape[-1], v.shape[-1]), jnp.float32)
    _, ys = lax.scan(step, S0, xs)
    return ys.transpose(1, 0, 3, 2, 4).reshape(B, L, H, v.shape[-1])


def hgrn2_mixer(q, f_pre, i, g, lb, norm_g):
    B, L, _ = q.shape
    split = lambda t: t.reshape(B, L, HG_HEADS, -1).astype(jnp.float32)
    qh = jax.nn.silu(split(q))
    lbh = lb.astype(jnp.float32).reshape(HG_HEADS, HG_DK)
    fgate = lbh + (1.0 - lbh) * jax.nn.sigmoid(split(f_pre))
    o = hgrn2_chunk_scan(qh, 1.0 - fgate, split(i), jnp.log(fgate))
    o = rms_norm(o, norm_g) * jax.nn.silu(split(g))
    return o.reshape(B, L, HG_WIDTH).astype(q.dtype)


def mla_mixer(c_q, c_kv, k_pe, q_norm_g, w_q_b, kv_norm_g, w_kv_b, cos, sin):
    B, L, _ = c_q.shape
    q = (rms_norm(c_q, q_norm_g) @ w_q_b).reshape(B, L, MLA_HEADS, QK_NOPE + QK_ROPE)
    q_nope = q[..., :QK_NOPE]
    q_pe = apply_rope(q[..., QK_NOPE:], cos[:, None, :], sin[:, None, :])
    kv = (rms_norm(c_kv, kv_norm_g) @ w_kv_b).reshape(B, L, MLA_HEADS, QK_NOPE + V_HEAD)
    k_nope, v = kv[..., :QK_NOPE], kv[..., QK_NOPE:]
    k_pe = apply_rope(k_pe, cos, sin)
    scale = (QK_NOPE + QK_ROPE) ** -0.5
    bounds = [(0, N_META)] + [(N_META + s, min(N_META + s + ATTN_BLOCK, L))
                              for s in range(0, L - N_META, ATTN_BLOCK)]
    outs = []
    for start, end in bounds:
        s = (jnp.einsum('bqhd,bkhd->bhqk', q_nope[:, start:end], k_nope[:, :end])
             + jnp.einsum('bqhr,bkr->bhqk', q_pe[:, start:end], k_pe[:, :end]))
        s = s.astype(jnp.float32) * scale
        qpos = jnp.arange(start, end)[:, None]
        kpos = jnp.arange(end)[None, :]
        s = jnp.where(kpos <= qpos, s, -jnp.inf)
        p = jax.nn.softmax(s, axis=-1).astype(v.dtype)
        outs.append(jnp.einsum('bhqk,bkhd->bqhd', p, v[:, :end]))
    o = jnp.concatenate(outs, axis=1)
    return o.reshape(B, L, MLA_HEADS * V_HEAD)


def setup_inputs(seed: int = 0) -> dict:
    key = jax.random.key(seed)
    ks = jax.random.split(key, 20)
    nrm = lambda k, shape, scale: jax.random.normal(k, shape, jnp.float32) * scale
    gain = lambda k, shape: 1.0 + 0.02 * jax.random.normal(k, shape, jnp.float32)
    return {
        "x": nrm(ks[0], (BATCH, SEQ, D_MODEL), 1.0),
        "meta_tokens": nrm(ks[1], (N_META, D_MODEL), 1.0),
        "w_in": nrm(ks[2], (DEPTH, D_MODEL, IN_COLS), D_MODEL ** -0.5),
        "b_gate": nrm(ks[3], (DEPTH, 2 * D_MODEL), 0.01),
        "lb_logits": nrm(ks[4], (DEPTH + 1, HG_WIDTH), 0.1),
        "hg_norm_g": gain(ks[5], (DEPTH, HG_DV)),
        "w_hg_o": nrm(ks[6], (DEPTH, HG_WIDTH, D_MODEL), HG_WIDTH ** -0.5),
        "q_a_norm_g": gain(ks[7], (DEPTH, Q_LORA)),
        "w_q_b": nrm(ks[8], (DEPTH, Q_LORA, MLA_HEADS * (QK_NOPE + QK_ROPE)), Q_LORA ** -0.5),
        "kv_a_norm_g": gain(ks[9], (DEPTH, KV_LORA)),
        "w_kv_b": nrm(ks[10], (DEPTH, KV_LORA, MLA_HEADS * (QK_NOPE + V_HEAD)), KV_LORA ** -0.5),
        "w_mla_o": nrm(ks[11], (DEPTH, MLA_HEADS * V_HEAD, D_MODEL), (MLA_HEADS * V_HEAD) ** -0.5),
        "w_out": nrm(ks[12], (DEPTH, D_MODEL, D_MODEL), D_MODEL ** -0.5),
        "mix_pre_g": gain(ks[13], (DEPTH, D_MODEL)),
        "mix_post_g": gain(ks[14], (DEPTH, D_MODEL)),
        "ffn_pre_g": gain(ks[15], (DEPTH, D_MODEL)),
        "ffn_post_g": gain(ks[16], (DEPTH, D_MODEL)),
        "w_ffn_in": nrm(ks[17], (DEPTH, D_MODEL, 2 * FFN_HIDDEN), D_MODEL ** -0.5),
        "w_ffn_out": nrm(ks[18], (DEPTH, FFN_HIDDEN, D_MODEL), FFN_HIDDEN ** -0.5),
    }


def reference(x, meta_tokens, w_in, b_gate, lb_logits, hg_norm_g, w_hg_o, q_a_norm_g, w_q_b,
              kv_a_norm_g, w_kv_b, w_mla_o, w_out, mix_pre_g, mix_post_g, ffn_pre_g, ffn_post_g,
              w_ffn_in, w_ffn_out):
    B = x.shape[0]
    meta = jnp.broadcast_to(meta_tokens[None].astype(x.dtype), (B, N_META, D_MODEL))
    h = jnp.concatenate([meta, x], axis=1)
    L = h.shape[1]
    cos, sin = rope_tables(L)
    lower_bounds = jnp.cumsum(jax.nn.softmax(lb_logits.astype(jnp.float32), axis=0), axis=0)
    splits = []
    acc = 0
    for sz in IN_SIZES[:-2]:
        acc += sz
        splits.append(acc)
    for l in range(DEPTH):
        u = rms_norm(h, mix_pre_g[l])
        proj = u @ w_in[l]
        hq, hf, hi, hg, cq, ckv, kpe, gates = jnp.split(proj, splits, axis=-1)
        y_a = hgrn2_mixer(hq, hf, hi, hg, lower_bounds[l], hg_norm_g[l]) @ w_hg_o[l]
        y_b = mla_mixer(cq, ckv, kpe, q_a_norm_g[l], w_q_b[l], kv_a_norm_g[l], w_kv_b[l],
                        cos, sin) @ w_mla_o[l]
        gate_a, gate_b = jnp.split(jax.nn.sigmoid(gates + b_gate[l]), 2, axis=-1)
        mixed = (gate_a * y_a + gate_b * y_b) @ w_out[l]
        h = h + rms_norm(mixed, mix_post_g[l])
        u = rms_norm(h, ffn_pre_g[l])
        gt, up = jnp.split(u @ w_ffn_in[l], 2, axis=-1)
        h = h + rms_norm((jax.nn.silu(gt) * up) @ w_ffn_out[l], ffn_post_g[l])
    return h[:, N_META:, :]
```

```cpp
#include <hip/hip_runtime.h>
#include <hip/hip_cooperative_groups.h>
#include <cstdio>
#include <cstdint>
namespace cg = cooperative_groups;
#define LAS __attribute__((address_space(3)))
typedef unsigned short bf16;
typedef float f32x4 __attribute__((ext_vector_type(4)));
typedef float f32x16 __attribute__((ext_vector_type(16)));
typedef short bf16x8 __attribute__((ext_vector_type(8)));
typedef short s16x4 __attribute__((ext_vector_type(4)));
typedef unsigned u32x4 __attribute__((ext_vector_type(4)));
typedef unsigned u32x2 __attribute__((ext_vector_type(2)));
constexpr int DM = 1024, NBATCH = 32, SEQ = 2048, MR = NBATCH * SEQ, NMETA = 16, MP = MR + 256;
constexpr int FFH = 2816, N_IN = 6912, NWAVES = 8, NTHREADS = 512;
constexpr float EPS = 1e-6f;
constexpr size_t MiB = 1u << 20;
constexpr size_t WS_SSQ = 0;
constexpr size_t WS_ROPE = 2 * MiB;
constexpr size_t WS_W = 4 * MiB;
constexpr size_t W_IN = WS_W, W_FIN = W_IN + (size_t)N_IN * DM * 2, W_FOUT = W_FIN + (size_t)2 * FFH * DM * 2, W_HGO = W_FOUT + (size_t)DM * FFH * 2,
                 W_MLAO = W_HGO + 2 * MiB, W_OUT = W_MLAO + 2 * MiB, W_QB = W_OUT + 2 * MiB, W_KVB = W_QB + (size_t)1536 * 256 * 2, W_END = W_KVB + (size_t)2048 * 256 * 2;
static_assert(W_END <= 48 * MiB, "weights");
constexpr size_t RSZ = 129 * MiB;
constexpr size_t WS_R0 = 48 * MiB, WS_R1 = WS_R0 + RSZ, WS_R2 = WS_R1 + RSZ, WS_R3 = WS_R2 + RSZ, WS_R4 = WS_R3 + RSZ, WS_R5 = WS_R4 + RSZ;
constexpr size_t WS_CQ = WS_R5 + RSZ, WS_CKV = WS_CQ + 33 * MiB, WS_KPE = WS_CKV + 33 * MiB, WS_PART = WS_KPE + 9 * MiB, WS_END = WS_PART + 12 * MiB;
constexpr size_t PART_Q = WS_PART, PART_KV = WS_PART + 2 * MiB, PART_1 = WS_PART + 4 * MiB, PART_2 = WS_PART + 8 * MiB;
static_assert((size_t)MP * DM * 2 <= RSZ && (size_t)MP * 256 * 2 <= 33 * MiB && (size_t)MP * 64 * 2 <= 9 * MiB && (size_t)MR * FFH * 2 <= 3 * RSZ, "ws map");
constexpr int LDS_BYTES = 147456, XB_LDS_OFF = 147456 - 256;
constexpr size_t WS_BAR = WS_SSQ + 1536 * 1024, WS_BAR_BYTES = 16384;

namespace pg8 {
#define PG8_LAS __attribute__((address_space(3)))
typedef unsigned short bf16_t;
typedef short bf16x8 __attribute__((ext_vector_type(8)));
typedef float f32x4 __attribute__((ext_vector_type(4)));
typedef unsigned u32x4 __attribute__((ext_vector_type(4)));
constexpr int BM = 256, BK = 64, HALF = 128, HTB = HALF * BK * 2  , STAGE_BYTES = 8 * HTB, NXCD = 8, WGM = 8;

__host__ __device__ __forceinline__ int lds_byte(int r, int c) { const int st = (r >> 4) * 2 + (c >> 5), rr = r & 15, cc = c & 31, ob = rr * 64 + cc * 2; return st * 1024 + (ob ^ (((ob >> 9) & 1) << 5)); }
__host__ __device__ __forceinline__ void stage_rc(int b, int& R, int& C) { const int st = b / 1024, sb = b % 1024, swz = sb ^ (((sb >> 9) & 1) << 5); R = (st >> 1) * 16 + swz / 64; C = (st & 1) * 32 + (swz % 64) / 2; }
__host__ __device__ __forceinline__ int perm32(int rho) { const int n = rho >> 4, i = rho & 15; return 8 * (i >> 2) + 4 * n + (i & 3); }

struct Unit { int pm, pn, sel; };
struct Gemm { const bf16_t* A; const bf16_t* Bt; int M, N, K; const bf16_t* A2; const bf16_t* Bt2; };

struct StaticOrder {
    int nM, nN, nwg, G, c;
    __host__ __device__ void init(int M, int N, int G_, int c_) { nM = M / BM; nN = N / BM; nwg = nM * nN; G = G_; c = c_; }
    __host__ __device__ bool next(int i, Unit& u) const {
        const long L = (long)i * G + c; if (L >= nwg) return false;
        int wgid = (int)L; { const int q = nwg / NXCD, r = nwg % NXCD, xcd = wgid % NXCD, off = wgid / NXCD; wgid = (xcd < r ? xcd * (q + 1) : r * (q + 1) + (xcd - r) * q) + off; }
        const int nig = WGM * nN, gid = wgid / nig, fm = gid * WGM, gsz = (nM - fm) < WGM ? (nM - fm) : WGM;
        u.pm = fm + ((wgid % nig) % gsz); u.pn = (wgid % nig) / gsz; u.sel = 0; return true;
    }
    __device__ __forceinline__ void a_ready(const Unit&) const {}
    __device__ __forceinline__ void done(const Unit&) const {}
};

typedef float cvt_f32x2 __attribute__((ext_vector_type(2))); typedef __bf16 cvt_bf16x2 __attribute__((ext_vector_type(2)));
__device__ __forceinline__ unsigned cvt_pk_bf16(float lo, float hi) { const cvt_f32x2 v = {lo, hi}; const cvt_bf16x2 b = __builtin_convertvector(v, cvt_bf16x2); return __builtin_bit_cast(unsigned, b); }
__device__ __forceinline__ u32x4 pack8(const f32x4 a, const f32x4 b) { u32x4 w; w.x = cvt_pk_bf16(a[0], a[1]); w.y = cvt_pk_bf16(a[2], a[3]); w.z = cvt_pk_bf16(b[0], b[1]); w.w = cvt_pk_bf16(b[2], b[3]); return w; }
__device__ __forceinline__ void unpack8(const u32x4 w, f32x4& a, f32x4& b) {
    a[0] = __uint_as_float(w.x << 16); a[1] = __uint_as_float(w.x & 0xffff0000u); a[2] = __uint_as_float(w.y << 16); a[3] = __uint_as_float(w.y & 0xffff0000u);
    b[0] = __uint_as_float(w.z << 16); b[1] = __uint_as_float(w.z & 0xffff0000u); b[2] = __uint_as_float(w.w << 16); b[3] = __uint_as_float(w.w & 0xffff0000u); }
__device__ __forceinline__ float sigm(float x) { return __builtin_amdgcn_rcpf(1.0f + __builtin_amdgcn_exp2f(x * -1.4426950408889634f)); }
__device__ __forceinline__ float sigm_new(float x) { return __builtin_amdgcn_rcpf(1.0f + __builtin_amdgcn_exp2f(x * -1.4426950408889634f)); }
__device__ __forceinline__ f32x4 sigm4_new(const f32x4 v) { f32x4 o; o[0] = sigm_new(v[0]); o[1] = sigm_new(v[1]); o[2] = sigm_new(v[2]); o[3] = sigm_new(v[3]); return o; }
__device__ __forceinline__ f32x4 silu4_new(const f32x4 v) { return v * sigm4_new(v); }
__device__ __forceinline__ f32x4 sigm4(const f32x4 v) { f32x4 o; o[0] = sigm(v[0]); o[1] = sigm(v[1]); o[2] = sigm(v[2]); o[3] = sigm(v[3]); return o; }
__device__ __forceinline__ f32x4 silu4(const f32x4 v) { return v * sigm4(v); }
constexpr int EP_MR = 65536;
constexpr float EP_EPS = 1e-6f;
__device__ __forceinline__ int pos_of_row(int r) { return r < EP_MR ? 16 + (r & 2047) : ((r - EP_MR) < 16 ? (r - EP_MR) : 0); }
__device__ __forceinline__ void rope4(f32x4& a, f32x4& b, const float* cs4) {
    const f32x4 t0 = ((const f32x4*)cs4)[0], t1 = ((const f32x4*)cs4)[1];
    const f32x4 c = {t0[0], t0[2], t1[0], t1[2]}, s = {t0[1], t0[3], t1[1], t1[3]};
    const f32x4 na = a * c - b * s, nb = b * c + a * s; a = na; b = nb;
}
__device__ __forceinline__ void rope8(f32x4& a0, f32x4& a1, f32x4& b0, f32x4& b1, const float* cs, int pos, int i0) {
    const float* t = cs + ((size_t)pos * 32 + i0) * 2;
    rope4(a0, b0, t); asm volatile("" ::: "memory"); rope4(a1, b1, t + 8);
}
#define EPI_ROWLOOP _Pragma("unroll") for (int ai = 0; ai < 2; ++ai) _Pragma("unroll") for (int m = 0; m < 4; ++m)

struct EpiInProj {
    static constexpr bool PERM = true, AFTER_DRAIN = false;
    bf16_t *HQ, *HF, *HI, *HG, *CQ, *CKV, *GATES, *KPE; float* ssq_q; float* ssq_kv; const float* b_gate; const float* ropecs;
    __device__ __forceinline__ void operator()(const f32x4 (&acc)[2][2][4][2], const Unit& u, int wr, int wc, int fr, int fq) const {
        const int pn = u.pn, row0 = u.pm * BM + wr * 64 + fr, cl = wc * 32 + 8 * fq;
        if (pn < 16) {
            bf16_t* base = pn < 4 ? HQ : pn < 8 ? HF : pn < 12 ? HI : HG; const bool act = (pn < 4) || (pn >= 12);
            const int col0 = (pn & 3) * 256 + cl;
            EPI_ROWLOOP { bf16_t* rowp = base + (size_t)(row0 + ai * HALF + m * 16) * 1024 + col0;
#pragma unroll
                for (int bj = 0; bj < 2; ++bj) { f32x4 v0 = acc[ai][bj][m][0], v1 = acc[ai][bj][m][1]; if (act) { v0 = silu4(v0); v1 = silu4(v1); }
                    *(u32x4*)(rowp + bj * HALF) = pack8(v0, v1); } }
        } else if (pn < 18) {
            bf16_t* base = pn == 16 ? CQ : CKV; float* part = pn == 16 ? ssq_q : ssq_kv;
            EPI_ROWLOOP { const int r = row0 + ai * HALF + m * 16; bf16_t* rowp = base + (size_t)r * 256 + cl; float s = 0.f;
#pragma unroll
                for (int bj = 0; bj < 2; ++bj) { const f32x4 v0 = acc[ai][bj][m][0], v1 = acc[ai][bj][m][1];
                    s += (v0[0] * v0[0] + v0[1] * v0[1]) + (v0[2] * v0[2] + v0[3] * v0[3]) + (v1[0] * v1[0] + v1[1] * v1[1]) + (v1[2] * v1[2] + v1[3] * v1[3]);
                    *(u32x4*)(rowp + bj * HALF) = pack8(v0, v1); }
                s += __shfl_xor(s, 16); s += __shfl_xor(s, 32);
                if (fq == 0) part[(size_t)r * 4 + wc] = s; }
        } else if (pn < 26) {
            if (u.pm * BM >= EP_MR) return;
            const int gc = (pn - 18) * 256 + cl;
            f32x4 bv[2][2];
#pragma unroll
            for (int bj = 0; bj < 2; ++bj) { bv[bj][0] = *(const f32x4*)(b_gate + gc + bj * HALF); bv[bj][1] = *(const f32x4*)(b_gate + gc + bj * HALF + 4); }
            EPI_ROWLOOP { bf16_t* rowp = GATES + (size_t)(row0 + ai * HALF + m * 16) * 2048 + gc;
#pragma unroll
                for (int bj = 0; bj < 2; ++bj) *(u32x4*)(rowp + bj * HALF) = pack8(sigm4(acc[ai][bj][m][0] + bv[bj][0]), sigm4(acc[ai][bj][m][1] + bv[bj][1])); }
        } else {
            if (wc != 0) return;
            EPI_ROWLOOP { const int r = row0 + ai * HALF + m * 16;
                f32x4 a0 = acc[ai][0][m][0], a1 = acc[ai][0][m][1], b0 = acc[ai][1][m][0], b1 = acc[ai][1][m][1];
                rope8(a0, a1, b0, b1, ropecs, pos_of_row(r), 8 * fq);
                bf16_t* rowp = KPE + (size_t)r * 64 + 8 * fq;
                *(u32x4*)(rowp) = pack8(a0, a1); *(u32x4*)(rowp + 32) = pack8(b0, b1); }
        }
    }
};
struct EpiQ {
    static constexpr bool PERM = true, AFTER_DRAIN = false;
    unsigned char* ws; float qscale;
    __device__ __forceinline__ void operator()(const f32x4 (&acc)[2][2][4][2], const Unit& u, int wr, int wc, int fr, int fq) const {
        typedef unsigned u32x2 __attribute__((ext_vector_type(2)));
        const int pn = u.pn, row0 = u.pm * BM + wr * 64 + fr, cl = wc * 32 + 8 * fq;
        const f32x4* part = (const f32x4*)(ws + PART_Q);
        if (pn < 4) {
            bf16_t* QN = (bf16_t*)(ws + WS_R1);
            EPI_ROWLOOP { const int r = row0 + ai * HALF + m * 16; const f32x4 pq = part[r]; const float rs = __builtin_amdgcn_rsqf(((pq[0] + pq[1]) + (pq[2] + pq[3])) * (1.0f / 256.0f) + EP_EPS) * qscale;
                bf16_t* rowp = QN + (size_t)r * 1024 + pn * 256 + cl;
#pragma unroll
                for (int bj = 0; bj < 2; ++bj) *(u32x4*)(rowp + bj * HALF) = pack8(acc[ai][bj][m][0] * rs, acc[ai][bj][m][1] * rs); }
        } else {
            bf16_t* QR = (bf16_t*)(ws + WS_R2); const float* ropecs = (const float*)(ws + WS_ROPE);
            EPI_ROWLOOP { const int r = row0 + ai * HALF + m * 16; const f32x4 pq = part[r]; const float rs = __builtin_amdgcn_rsqf(((pq[0] + pq[1]) + (pq[2] + pq[3])) * (1.0f / 256.0f) + EP_EPS) * qscale;
                const float* t = ropecs + ((size_t)pos_of_row(r) * 32 + 8 * fq) * 2;
                bf16_t* rowp = QR + (size_t)r * 512 + (4 * (pn - 4) + wc) * 64 + 8 * fq;
#pragma unroll
                for (int n = 0; n < 2; ++n) { f32x4 a = acc[ai][0][m][n], b = acc[ai][1][m][n]; rope4(a, b, t + 8 * n); a = a * rs; b = b * rs;
                    *(u32x2*)(rowp + 4 * n) = (u32x2){cvt_pk_bf16(a[0], a[1]), cvt_pk_bf16(a[2], a[3])}; *(u32x2*)(rowp + 32 + 4 * n) = (u32x2){cvt_pk_bf16(b[0], b[1]), cvt_pk_bf16(b[2], b[3])};
                    asm volatile("" ::: "memory"); } }
        }
    }
};
struct EpiKV {
    static constexpr bool PERM = true, AFTER_DRAIN = false;
    bf16_t *KN, *VV; const f32x4* part;
    __device__ __forceinline__ void operator()(const f32x4 (&acc)[2][2][4][2], const Unit& u, int wr, int wc, int fr, int fq) const {
        const int pn = u.pn, row0 = u.pm * BM + wr * 64 + fr, cl = wc * 32 + 8 * fq;
        bf16_t* base = pn < 4 ? KN : VV;
        EPI_ROWLOOP { const int r = row0 + ai * HALF + m * 16; const f32x4 pq = part[r]; const float rs = __builtin_amdgcn_rsqf(((pq[0] + pq[1]) + (pq[2] + pq[3])) * (1.0f / 256.0f) + EP_EPS);
            bf16_t* rowp = base + (size_t)r * 1024 + (pn & 3) * 256 + cl;
#pragma unroll
            for (int bj = 0; bj < 2; ++bj) *(u32x4*)(rowp + bj * HALF) = pack8(acc[ai][bj][m][0] * rs, acc[ai][bj][m][1] * rs); }
    }
};
struct EpiMix {
    static constexpr bool PERM = true, AFTER_DRAIN = false;
    const bf16_t* GATES; bf16_t* T; bf16_t* MIX;
    __device__ __forceinline__ void operator()(const f32x4 (&acc)[2][2][4][2], const Unit& u, int wr, int wc, int fr, int fq) const {
        const int row0 = u.pm * BM + wr * 64 + fr, c0 = u.pn * 256 + wc * 32 + 8 * fq;
        EPI_ROWLOOP { const int r = row0 + ai * HALF + m * 16;
#pragma unroll
            for (int bj = 0; bj < 2; ++bj) { const int c = c0 + bj * HALF; f32x4 g0, g1; unpack8(*(const u32x4*)(GATES + (size_t)r * 2048 + (u.sel ? 1024 : 0) + c), g0, g1);
                f32x4 v0 = acc[ai][bj][m][0] * g0, v1 = acc[ai][bj][m][1] * g1;
                if (u.sel) { f32x4 t0, t1; unpack8(*(const u32x4*)(T + (size_t)r * 1024 + c), t0, t1); v0 += t0; v1 += t1; *(u32x4*)(MIX + (size_t)r * 1024 + c) = pack8(v0, v1); }
                else *(u32x4*)(T + (size_t)r * 1024 + c) = pack8(v0, v1); } }
    }
};
struct EpiYSsq {
    static constexpr bool PERM = true, AFTER_DRAIN = false;
    bf16_t* Y; float* part;
    __device__ __forceinline__ void operator()(const f32x4 (&acc)[2][2][4][2], const Unit& u, int wr, int wc, int fr, int fq) const {
        const int row0 = u.pm * BM + wr * 64 + fr, c0 = u.pn * 256 + wc * 32 + 8 * fq;
        EPI_ROWLOOP { const int r = row0 + ai * HALF + m * 16; bf16_t* rowp = Y + (size_t)r * 1024 + c0; float s = 0.f;
#pragma unroll
            for (int bj = 0; bj < 2; ++bj) { const f32x4 v0 = acc[ai][bj][m][0], v1 = acc[ai][bj][m][1];
                s += (v0[0] * v0[0] + v0[1] * v0[1]) + (v0[2] * v0[2] + v0[3] * v0[3]) + (v1[0] * v1[0] + v1[1] * v1[1]) + (v1[2] * v1[2] + v1[3] * v1[3]);
                *(u32x4*)(rowp + bj * HALF) = pack8(v0, v1); }
            s += __shfl_xor(s, 16); s += __shfl_xor(s, 32);
            if (fq == 0) part[(size_t)r * 16 + u.pn * 4 + wc] = s; }
    }
};
struct EpiSwiglu {
    static constexpr bool PERM = true, AFTER_DRAIN = false;
    bf16_t* HID; int ldh;
    __device__ __forceinline__ void operator()(const f32x4 (&acc)[2][2][4][2], const Unit& u, int wr, int wc, int fr, int fq) const {
        const int row0 = u.pm * BM + wr * 64 + fr, c0 = u.pn * 128 + wc * 32 + 8 * fq;
        EPI_ROWLOOP { const int r = row0 + ai * HALF + m * 16;
            *(u32x4*)(HID + (size_t)r * ldh + c0) = pack8(silu4_new(acc[ai][0][m][0]) * acc[ai][1][m][0], silu4_new(acc[ai][0][m][1]) * acc[ai][1][m][1]); }
    }
};
struct PairOrder {
    StaticOrder so;
    __device__ bool next(int i, Unit& u) const { if (!so.next(i >> 1, u)) return false; u.sel = i & 1; return true; }
    __device__ __forceinline__ void a_ready(const Unit&) const {}
    __device__ __forceinline__ void done(const Unit&) const {}
};
template <class Epi, class Sched, bool ALIGN_EPI = false, bool SP2 = false>
__device__ __forceinline__ void gemm_phase(PG8_LAS unsigned char* lds, const Gemm g, const Sched& S, const Epi& E) {
    int tid_ = threadIdx.x; asm volatile("" : "+v"(tid_));
    const int tid = tid_, wid = __builtin_amdgcn_readfirstlane(tid >> 6), lane = tid & 63, wr = wid >> 2, wc = wid & 3, fr = lane & 15, fq = lane >> 4;
    int K_ = g.K; asm volatile("" : "+s"(K_));
    const int K = K_, nt = K / BK;
    unsigned voffA[2], voffB[2];
#pragma unroll
    for (int i = 0; i < 2; ++i) { int R, C; stage_rc(tid * 16 + i * 8192, R, C); const int Rb = Epi::PERM ? ((R & ~31) + perm32(R & 31)) : R;
        voffA[i] = (unsigned)(R * K + C) * 2u; voffB[i] = (unsigned)(Rb * K + C) * 2u; }
    const size_t kstep = (size_t)(BK * 2);
    const size_t hstep = (size_t)HALF * K * 2;
    const size_t tstep = 2 * hstep;
    const unsigned ldsw = (unsigned)wid * 1024u;
    const int aoff = lds_byte(wr * 64 + fr, fq * 8), boff = lds_byte(wc * 32 + fr, fq * 8);
#define PG8_SA(b, h) (((b) * 2 + (h)) * HTB)
#define PG8_SB(b, h) ((4 + (b) * 2 + (h)) * HTB)
#define PG8_STAGE(bufoff, gbase, voff) do { _Pragma("unroll") for (int _i = 0; _i < 2; ++_i) \
        __builtin_amdgcn_global_load_lds((const unsigned*)((const char*)(gbase) + (voff)[_i]), (PG8_LAS unsigned*)(lds + (bufoff) + ldsw + _i * 8192), 16, 0, 0); } while (0)
#define PG8_LDA(dst, b, h) do { _Pragma("unroll") for (int m = 0; m < 4; ++m) _Pragma("unroll") for (int k = 0; k < 2; ++k) dst[m][k] = *(const PG8_LAS bf16x8*)(lds + PG8_SA(b, h) + aoff + m * 2048 + k * 1024); } while (0)
#define PG8_LDB(dst, b, h) do { _Pragma("unroll") for (int n = 0; n < 2; ++n) _Pragma("unroll") for (int k = 0; k < 2; ++k) dst[n][k] = *(const PG8_LAS bf16x8*)(lds + PG8_SB(b, h) + boff + n * 2048 + k * 1024); } while (0)
#define PG8_MMA(ai, bj, At, Bt) do { __builtin_amdgcn_s_setprio(1); _Pragma("unroll") for (int m = 0; m < 4; ++m) _Pragma("unroll") for (int n = 0; n < 2; ++n) _Pragma("unroll") for (int k = 0; k < 2; ++k) \
        acc[ai][bj][m][n] = __builtin_amdgcn_mfma_f32_16x16x32_bf16(Bt[n][k], At[m][k], acc[ai][bj][m][n], 0, 0, 0); __builtin_amdgcn_s_setprio(0); } while (0)
#define PG8_WAIT_V(n) asm volatile("s_waitcnt vmcnt(" #n ")" ::: "memory")
#define PG8_WAIT_L(n) asm volatile("s_waitcnt lgkmcnt(" #n ")" ::: "memory")
#define PG8_BAR __builtin_amdgcn_s_barrier()
#define PG8_SCHED __builtin_amdgcn_sched_barrier(0)
    Unit cur, nxt; int ui = 0;
    if (!S.next(0, cur)) return;
    f32x4 acc[2][2][4][2];
#pragma unroll
    for (int a = 0; a < 2; ++a)
#pragma unroll
        for (int b = 0; b < 2; ++b)
#pragma unroll
            for (int m = 0; m < 4; ++m)
#pragma unroll
                for (int n = 0; n < 2; ++n) acc[a][b][m][n] = (f32x4){0.f, 0.f, 0.f, 0.f};
    bf16x8 At[4][2], B0[2][2], B1[2][2];
    const char* cA = (const char*)(cur.sel ? g.A2 : g.A) + (size_t)cur.pm * tstep; const char* cB = (const char*)(cur.sel ? g.Bt2 : g.Bt) + (size_t)cur.pn * tstep;
    S.a_ready(cur);
    if constexpr (SP2) {
        PG8_STAGE(PG8_SB(0, 0), cB, voffB); PG8_STAGE(PG8_SB(0, 1), cB + hstep, voffB); PG8_STAGE(PG8_SA(0, 0), cA, voffA); PG8_STAGE(PG8_SA(0, 1), cA + hstep, voffA);
        if (wr == 1) PG8_BAR;
        PG8_WAIT_V(2); PG8_BAR;
        PG8_STAGE(PG8_SB(1, 0), cB + kstep, voffB); PG8_STAGE(PG8_SA(1, 0), cA + kstep, voffA); PG8_STAGE(PG8_SB(1, 1), cB + hstep + kstep, voffB);
        PG8_WAIT_V(6); PG8_BAR;
    } else {
        PG8_STAGE(PG8_SB(0, 0), cB, voffB); PG8_STAGE(PG8_SA(0, 0), cA, voffA); PG8_STAGE(PG8_SB(0, 1), cB + hstep, voffB); PG8_STAGE(PG8_SA(0, 1), cA + hstep, voffA);
        if (wr == 1) PG8_BAR;
        PG8_WAIT_V(4); PG8_BAR;
        PG8_STAGE(PG8_SB(1, 0), cB + kstep, voffB); PG8_STAGE(PG8_SA(1, 0), cA + kstep, voffA); PG8_STAGE(PG8_SB(1, 1), cB + hstep + kstep, voffB);
        PG8_WAIT_V(6); PG8_BAR;
    }
    for (;;) {
        const bool has_next = S.next(ui + 1, nxt);
        const char* nA = has_next ? (const char*)(nxt.sel ? g.A2 : g.A) + (size_t)nxt.pm * tstep : cA; const char* nB = has_next ? (const char*)(nxt.sel ? g.Bt2 : g.Bt) + (size_t)nxt.pn * tstep : cB;
        for (int t = 0; t < nt; t += 2) {
            const bool last = (t == nt - 2);
            const char* a1 = cA + (size_t)(t + 1) * kstep;
            const char* a2 = last ? nA : cA + (size_t)(t + 2) * kstep; const char* b2 = last ? nB : cB + (size_t)(t + 2) * kstep;
            const char* a3 = a2 + kstep; const char* b3 = b2 + kstep;
            if (last && has_next) S.a_ready(nxt);
            if constexpr (SP2) {
            PG8_LDB(B0, 0, 0); PG8_LDB(B1, 0, 1); PG8_SCHED; PG8_LDA(At, 0, 0); PG8_STAGE(PG8_SA(1, 1), a1 + hstep, voffA);
            PG8_WAIT_V(8); PG8_WAIT_L(0); PG8_BAR; PG8_MMA(0, 0, At, B0); PG8_MMA(0, 1, At, B1); PG8_BAR; PG8_SCHED;
            PG8_LDA(At, 0, 1); PG8_STAGE(PG8_SB(0, 0), b2, voffB); PG8_STAGE(PG8_SB(0, 1), b2 + hstep, voffB); PG8_STAGE(PG8_SA(0, 0), a2, voffA);
            PG8_WAIT_V(8); PG8_WAIT_L(0); PG8_BAR; PG8_MMA(1, 0, At, B0); PG8_MMA(1, 1, At, B1); PG8_BAR; PG8_SCHED;
            PG8_LDB(B0, 1, 0); PG8_LDB(B1, 1, 1); PG8_SCHED; PG8_LDA(At, 1, 0); PG8_STAGE(PG8_SA(0, 1), a2 + hstep, voffA);
            PG8_WAIT_V(8); PG8_WAIT_L(0); PG8_BAR; PG8_MMA(0, 0, At, B0); PG8_MMA(0, 1, At, B1); PG8_BAR; PG8_SCHED;
            PG8_LDA(At, 1, 1); PG8_STAGE(PG8_SB(1, 0), b3, voffB); PG8_STAGE(PG8_SB(1, 1), b3 + hstep, voffB); PG8_STAGE(PG8_SA(1, 0), a3, voffA);
            PG8_WAIT_V(8); PG8_WAIT_L(0); PG8_BAR; PG8_MMA(1, 0, At, B0); PG8_MMA(1, 1, At, B1); PG8_BAR; PG8_SCHED;
            } else {
            PG8_LDB(B0, 0, 0); PG8_SCHED; PG8_LDA(At, 0, 0); PG8_STAGE(PG8_SA(1, 1), a1 + hstep, voffA);
            PG8_WAIT_L(8); PG8_BAR; PG8_WAIT_L(0); PG8_MMA(0, 0, At, B0); PG8_BAR; PG8_SCHED;
            PG8_LDB(B1, 0, 1); PG8_STAGE(PG8_SB(0, 0), b2, voffB);
            PG8_BAR; PG8_WAIT_L(0); PG8_MMA(0, 1, At, B1); PG8_BAR;
            PG8_LDA(At, 0, 1); PG8_STAGE(PG8_SA(0, 0), a2, voffA);
            PG8_BAR; PG8_WAIT_L(0); PG8_MMA(1, 0, At, B0); PG8_BAR; PG8_SCHED;
            PG8_STAGE(PG8_SB(0, 1), b2 + hstep, voffB);
            PG8_WAIT_V(6); PG8_BAR; PG8_MMA(1, 1, At, B1); PG8_BAR;
            PG8_LDB(B0, 1, 0); PG8_SCHED; PG8_LDA(At, 1, 0); PG8_STAGE(PG8_SA(0, 1), a2 + hstep, voffA);
            PG8_WAIT_L(8); PG8_BAR; PG8_WAIT_L(0); PG8_MMA(0, 0, At, B0); PG8_BAR; PG8_SCHED;
            PG8_LDB(B1, 1, 1); PG8_STAGE(PG8_SB(1, 0), b3, voffB);
            PG8_BAR; PG8_WAIT_L(0); PG8_MMA(0, 1, At, B1); PG8_BAR;
            PG8_LDA(At, 1, 1); PG8_STAGE(PG8_SA(1, 0), a3, voffA);
            PG8_BAR; PG8_WAIT_L(0); PG8_MMA(1, 0, At, B0); PG8_BAR; PG8_SCHED;
            PG8_STAGE(PG8_SB(1, 1), b3 + hstep, voffB);
            PG8_WAIT_V(6); PG8_BAR; PG8_MMA(1, 1, At, B1); PG8_BAR;
            }
        }
        if constexpr (ALIGN_EPI) { if (wr == 0) PG8_BAR; }
        if constexpr (!Epi::AFTER_DRAIN) { E(acc, cur, wr, wc, fr, fq); S.done(cur); }
        if (!has_next) break;
#pragma unroll
        for (int a = 0; a < 2; ++a)
#pragma unroll
            for (int b = 0; b < 2; ++b)
#pragma unroll
                for (int m = 0; m < 4; ++m)
#pragma unroll
                    for (int n = 0; n < 2; ++n) acc[a][b][m][n] = (f32x4){0.f, 0.f, 0.f, 0.f};
        cur = nxt; cA = nA; cB = nB; ++ui;
        if constexpr (ALIGN_EPI) { if (wr == 1) PG8_BAR; }
    }
    PG8_WAIT_V(0);
    if constexpr (!ALIGN_EPI) { if (wr == 0) PG8_BAR; }
    PG8_BAR;
    if constexpr (Epi::AFTER_DRAIN) { E.fused(acc, cur, wr, wc, fr, fq, lds, wid, lane); S.done(cur); }
#undef PG8_SA
#undef PG8_SB
#undef PG8_STAGE
#undef PG8_LDA
#undef PG8_LDB
#undef PG8_MMA
#undef PG8_WAIT_V
#undef PG8_WAIT_L
#undef PG8_BAR
#undef PG8_SCHED
}
}

struct Params {
    const float *x, *meta, *w_in, *b_gate, *lb_logits, *hg_norm_g, *w_hg_o, *q_a_norm_g, *w_q_b, *kv_a_norm_g, *w_kv_b, *w_mla_o, *w_out, *mix_pre_g, *mix_post_g, *ffn_pre_g, *ffn_post_g, *w_ffn_in, *w_ffn_out;
    float* out; unsigned char* ws;
};

#define LDS_WAIT() asm volatile("s_waitcnt lgkmcnt(0)" ::: "memory")
__device__ __forceinline__ unsigned cvtpk(float lo, float hi) { return pg8::cvt_pk_bf16(lo, hi); }
__device__ __forceinline__ float bf_lo(unsigned w) { return __uint_as_float(w << 16); }
__device__ __forceinline__ float bf_hi(unsigned w) { return __uint_as_float(w & 0xffff0000u); }
__device__ __forceinline__ float wave_sum(float v) {
#pragma unroll
    for (int o = 1; o < 64; o <<= 1) v += __shfl_xor(v, o);
    return v;
}
__device__ __forceinline__ float sigmf(float x) { return 1.0f / (1.0f + __expf(-x)); }

__device__ __forceinline__ void tr_item(const float* W, int K, int N, bf16* WT, int kb, int drow0, int n0, const float* gain, LAS float* scr, int lane) {
    const int k0 = 64 * kb;
#pragma unroll 8
    for (int i = 0; i < 32; ++i) { const int kk = 2 * i + (lane >> 5); float v = 0.f;
        if (n0 >= 0) { v = W[(size_t)(k0 + kk) * N + n0 + (lane & 31)]; if (gain) v *= gain[k0 + kk]; }
        scr[kk * 33 + (lane & 31)] = v; }
    LDS_WAIT(); asm volatile("" ::: "memory");
    const int c = lane & 7;
#pragma unroll
    for (int j = 0; j < 4; ++j) { const int n = (lane >> 3) + 8 * j; const LAS float* s = scr + (8 * c) * 33 + n;
        u32x4 o; o.x = cvtpk(s[0 * 33], s[1 * 33]); o.y = cvtpk(s[2 * 33], s[3 * 33]); o.z = cvtpk(s[4 * 33], s[5 * 33]); o.w = cvtpk(s[6 * 33], s[7 * 33]);
        *(u32x4*)(WT + (size_t)(drow0 + n) * K + k0 + 8 * c) = o; }
    LDS_WAIT(); asm volatile("" ::: "memory");
}
__device__ __forceinline__ int map_win(int db) { if (db < 144) return db * 32; if (db < 208) return db * 32 + 64; const int t = db - 208; return t == 0 ? 4608 : (t == 4 ? 4640 : -1); }
__device__ __forceinline__ int map_wqb(int db) { if (db < 32) return (db >> 2) * 192 + (db & 3) * 32; const int e = db - 32, t = e >> 3, bj = (e & 7) >> 2, hh = e & 3; return (4 * t + hh) * 192 + 128 + bj * 32; }
__device__ __forceinline__ int map_wkvb(int db) { if (db < 32) return (db >> 2) * 256 + (db & 3) * 32; const int e = db - 32; return (e >> 2) * 256 + 128 + (e & 3) * 32; }
__device__ __forceinline__ int map_wfin(int db) { const int t = db >> 3, bj = (db & 7) >> 2, jj = db & 3; return bj * FFH + t * 128 + jj * 32; }

__device__ __forceinline__ void p0_prologue(const Params& p, LAS unsigned char* lds) {
    int tid_ = threadIdx.x; asm volatile("" : "+v"(tid_));
    const int tid = tid_, lane = tid & 63, wave = tid >> 6, G = gridDim.x;
    const int gw = blockIdx.x * NWAVES + wave, NGW = G * NWAVES;
    const int gt = blockIdx.x * NTHREADS + tid, NGT = G * NTHREADS;
    unsigned char* ws = p.ws;
    { float* cs = (float*)(ws + WS_ROPE);
      for (int e = gt; e < (SEQ + NMETA) * 32; e += NGT) { const int pos = e >> 5, i = e & 31;
          double f = 1.0; { const double r1 = 0.74989420933245582730218427561514, r2 = r1 * r1, r4 = r2 * r2, r8 = r4 * r4, r16 = r8 * r8;
              if (i & 1) f *= r1; if (i & 2) f *= r2; if (i & 4) f *= r4; if (i & 8) f *= r8; if (i & 16) f *= r16; }
          double a = (double)pos * f; const double TWO_PI = 6.283185307179586476925286766559; a -= TWO_PI * __builtin_rint(a / TWO_PI);
          const double a2 = a * a; double sc = 1.0, ss = a, tc = 1.0, ts = a;
#pragma unroll 1
          for (int n = 1; n <= 14; ++n) { tc *= -a2 / (double)((2 * n - 1) * (2 * n)); ts *= -a2 / (double)((2 * n) * (2 * n + 1)); sc += tc; ss += ts; }
          cs[2 * e] = (float)sc; cs[2 * e + 1] = (float)ss; } }
    { LAS float* scr = (LAS float*)(lds + wave * 16384);
      constexpr int I0 = 16 * 216, I1 = 4 * 48, I2 = 4 * 64, I3 = 16 * 32, I6 = 16 * 176, I7 = 44 * 32;
      constexpr int NIT = I0 + I1 + I2 + 3 * I3 + I6 + I7;
      for (int it = gw; it < NIT; it += NGW) { int r = it;
          if (r < I0) { const int kb = r / 216, db = r % 216; tr_item(p.w_in, 1024, 6720, (bf16*)(ws + W_IN), kb, db * 32, map_win(db), nullptr, scr, lane); continue; } r -= I0;
          if (r < I1) { const int kb = r / 48, db = r % 48; tr_item(p.w_q_b, 256, 1536, (bf16*)(ws + W_QB), kb, db * 32, map_wqb(db), p.q_a_norm_g, scr, lane); continue; } r -= I1;
          if (r < I2) { const int kb = r / 64, db = r % 64; tr_item(p.w_kv_b, 256, 2048, (bf16*)(ws + W_KVB), kb, db * 32, map_wkvb(db), p.kv_a_norm_g, scr, lane); continue; } r -= I2;
          if (r < I3) { const int kb = r / 32, db = r % 32; tr_item(p.w_hg_o, 1024, 1024, (bf16*)(ws + W_HGO), kb, db * 32, db * 32, nullptr, scr, lane); continue; } r -= I3;
          if (r < I3) { const int kb = r / 32, db = r % 32; tr_item(p.w_mla_o, 1024, 1024, (bf16*)(ws + W_MLAO), kb, db * 32, db * 32, nullptr, scr, lane); continue; } r -= I3;
          if (r < I3) { const int kb = r / 32, db = r % 32; tr_item(p.w_out, 1024, 1024, (bf16*)(ws + W_OUT), kb, db * 32, db * 32, nullptr, scr, lane); continue; } r -= I3;
          if (r < I6) { const int kb = r / 176, db = r % 176; tr_item(p.w_ffn_in, 1024, 2 * FFH, (bf16*)(ws + W_FIN), kb, db * 32, map_wfin(db), nullptr, scr, lane); continue; } r -= I6;
          { const int kb = r / 32, db = r % 32; tr_item(p.w_ffn_out, FFH, 1024, (bf16*)(ws + W_FOUT), kb, db * 32, db * 32, nullptr, scr, lane); } } }
    { bf16* U = (bf16*)(ws + WS_R0);
      f32x4 gg[4];
#pragma unroll
      for (int j = 0; j < 4; ++j) gg[j] = *(const f32x4*)(p.mix_pre_g + 4 * lane + 256 * j);
      for (int r = gw; r < MP; r += 2 * NGW) {
          f32x4 v[2][4];
#pragma unroll
          for (int q = 0; q < 2; ++q) { const int rq = r + q * NGW;
#pragma unroll
              for (int j = 0; j < 4; ++j) v[q][j] = (f32x4){0.f, 0.f, 0.f, 0.f};
              if (rq < MR + NMETA) { const float* src = rq < MR ? p.x + (size_t)rq * DM : p.meta + (size_t)(rq - MR) * DM;
#pragma unroll
                  for (int j = 0; j < 4; ++j) v[q][j] = *(const f32x4*)(src + 4 * lane + 256 * j); } }
#pragma unroll
          for (int q = 0; q < 2; ++q) { const int rq = r + q * NGW; if (rq >= MP) break;
              u32x2* o8 = (u32x2*)(U + (size_t)rq * DM) + lane; float s = 0.f;
#pragma unroll
              for (int j = 0; j < 4; ++j) s += (v[q][j][0] * v[q][j][0] + v[q][j][1] * v[q][j][1]) + (v[q][j][2] * v[q][j][2] + v[q][j][3] * v[q][j][3]);
              const float rstd = __builtin_amdgcn_rsqf(wave_sum(s) * (1.0f / DM) + EPS);
#pragma unroll
              for (int j = 0; j < 4; ++j) { const f32x4 w = v[q][j] * rstd * gg[j]; o8[64 * j] = (u32x2){cvtpk(w[0], w[1]), cvtpk(w[2], w[3])}; } } } }
}

__device__ __forceinline__ void scan_phase(const Params& p, LAS unsigned char* lds) {
    const bf16* HQ = (const bf16*)(p.ws + WS_R1); const bf16* HF = (const bf16*)(p.ws + WS_R2); bf16* HIO = (bf16*)(p.ws + WS_R3); const bf16* HG = (const bf16*)(p.ws + WS_R4);
    LAS float* fS = (LAS float*)lds; LAS float* kS = fS + 2048; LAS float* qS = kS + 2048; LAS float* vS = qS + 2048; LAS float* gS = vS + 2048; LAS float* oP = gS + 2048;
    int tid_ = threadIdx.x; asm volatile("" : "+v"(tid_));
    const int tid = tid_, v = tid & 127, kq = tid >> 7, ls = tid >> 5, lk = (tid & 31) * 4;
    for (int item = blockIdx.x; item < NBATCH * 8; item += gridDim.x) {
        const int b = item >> 3, h = item & 7;
        float lbv[4], gn[4];
#pragma unroll
        for (int e = 0; e < 4; ++e) { const float l0 = p.lb_logits[h * 128 + lk + e], l1 = p.lb_logits[1024 + h * 128 + lk + e]; lbv[e] = 1.0f / (1.0f + __expf(l1 - l0)); gn[e] = p.hg_norm_g[lk + e]; }
        float S[32];
#pragma unroll
        for (int j = 0; j < 32; ++j) S[j] = 0.f;
        u32x2 rq, rf, ri, rg;
        { const size_t off = (size_t)(MR + ls) * DM + h * 128 + lk; rq = *(const u32x2*)(HQ + off); rf = *(const u32x2*)(HF + off); ri = *(const u32x2*)(HIO + off); rg = *(const u32x2*)(HG + off); }
        for (int ch = 0; ch <= 128; ++ch) {
            const int row0 = ch == 0 ? MR : b * SEQ + (ch - 1) * 16;
            { const float fx[4] = {bf_lo(rf.x), bf_hi(rf.x), bf_lo(rf.y), bf_hi(rf.y)};
              f32x4 f4, k4;
#pragma unroll
              for (int e = 0; e < 4; ++e) { const float f = lbv[e] + (1.0f - lbv[e]) * sigmf(fx[e]); f4[e] = f; k4[e] = 1.0f - f; }
              *(LAS f32x4*)(fS + ls * 128 + lk) = f4; *(LAS f32x4*)(kS + ls * 128 + lk) = k4;
              *(LAS f32x4*)(qS + ls * 128 + lk) = (f32x4){bf_lo(rq.x), bf_hi(rq.x), bf_lo(rq.y), bf_hi(rq.y)};
              *(LAS f32x4*)(vS + ls * 128 + lk) = (f32x4){bf_lo(ri.x), bf_hi(ri.x), bf_lo(ri.y), bf_hi(ri.y)};
              *(LAS f32x4*)(gS + ls * 128 + lk) = (f32x4){bf_lo(rg.x), bf_hi(rg.x), bf_lo(rg.y), bf_hi(rg.y)}; }
            __syncthreads();
            if (ch < 128) { const size_t off = (size_t)(b * SEQ + ch * 16 + ls) * DM + h * 128 + lk; rq = *(const u32x2*)(HQ + off); rf = *(const u32x2*)(HF + off); ri = *(const u32x2*)(HIO + off); rg = *(const u32x2*)(HG + off); }
#pragma unroll 2
            for (int s = 0; s < 16; ++s) { const float vv = vS[s * 128 + v]; float oa = 0.f;
#pragma unroll
                for (int j4 = 0; j4 < 8; ++j4) { const f32x4 f4 = *(const LAS f32x4*)(fS + s * 128 + 32 * kq + 4 * j4), k4 = *(const LAS f32x4*)(kS + s * 128 + 32 * kq + 4 * j4), q4 = *(const LAS f32x4*)(qS + s * 128 + 32 * kq + 4 * j4);
#pragma unroll
                    for (int e = 0; e < 4; ++e) { S[4 * j4 + e] = f4[e] * S[4 * j4 + e] + k4[e] * vv; oa += q4[e] * S[4 * j4 + e]; } }
                oP[(kq * 16 + s) * 128 + v] = oa; __builtin_amdgcn_sched_barrier(0); }
            __syncthreads();
            if (ch > 0) {
                f32x4 o4 = *(const LAS f32x4*)(oP + (0 * 16 + ls) * 128 + lk);
                o4 += *(const LAS f32x4*)(oP + (1 * 16 + ls) * 128 + lk); o4 += *(const LAS f32x4*)(oP + (2 * 16 + ls) * 128 + lk); o4 += *(const LAS f32x4*)(oP + (3 * 16 + ls) * 128 + lk);
                float ss = (o4[0] * o4[0] + o4[1] * o4[1]) + (o4[2] * o4[2] + o4[3] * o4[3]);
#pragma unroll
                for (int o = 1; o < 32; o <<= 1) ss += __shfl_xor(ss, o);
                const float rstd = __builtin_amdgcn_rsqf(ss * (1.0f / 128.0f) + EPS);
                const f32x4 g4 = *(const LAS f32x4*)(gS + ls * 128 + lk);
                const float o0 = o4[0] * rstd * gn[0] * g4[0], o1 = o4[1] * rstd * gn[1] * g4[1], o2 = o4[2] * rstd * gn[2] * g4[2], o3 = o4[3] * rstd * gn[3] * g4[3];
                *(u32x2*)(HIO + (size_t)(row0 + ls) * DM + h * 128 + lk) = (u32x2){cvtpk(o0, o1), cvtpk(o2, o3)};
            }
            __syncthreads();
        }
    }
}

struct ScanRaw { u32x4 a, b; };
struct ScanSt { s16x4 vf; float gv[4]; };
constexpr int SC_QD = 0, SC_KI = 4352, SC_KST = 8704, SC_DEC = 12800, SC_SSQ = 13312, SC_BUF = 16384, SC_RS = 272, SC_RAW = 2 * SC_BUF, SC_RAWSZ = 16384;
__device__ __forceinline__ float bf2f(unsigned h) { return __uint_as_float(h << 16); }
__device__ __forceinline__ void scan_load(ScanRaw& r, const bf16* P0, const bf16* P1, size_t off) { r.a = *(const u32x4*)(P0 + off); r.b = *(const u32x4*)(P1 + off); }
__device__ __forceinline__ void scan_stage(const ScanRaw& r, LAS unsigned char* raw, int tid) {
    const int row = (tid >> 4) & 15, slot = ((tid & 15) + 2 * (row >> 2)) & 15; LAS unsigned char* d = raw + (tid >> 8) * 4096 + row * 256 + slot * 16;
    *(LAS u32x4*)(d) = r.a; *(LAS u32x4*)(d + 8192) = r.b;
}
__device__ __forceinline__ void scan_gate(const LAS unsigned char* raw, ScanSt& st, LAS unsigned char* buf, float lb, int w, int l16, int g) {
    const float L2E = 1.4426950408889634f;
    const LAS unsigned char* e = raw + (4 * g) * 256 + ((2 * w + (l16 >> 3) + 2 * g) & 15) * 16 + (l16 & 7) * 2;
    unsigned rq[4], rf[4], rv[4], rg[4];
#pragma unroll
    for (int j = 0; j < 4; ++j) { rq[j] = *(const LAS unsigned short*)(e + j * 256); rf[j] = *(const LAS unsigned short*)(e + 4096 + j * 256); rv[j] = *(const LAS unsigned short*)(e + 8192 + j * 256); rg[j] = *(const LAS unsigned short*)(e + 12288 + j * 256); }
    float qv[4], kk[4], cs[4]; float run = 0.f;
#pragma unroll
    for (int j = 0; j < 4; ++j) { const float x = bf2f(rf[j]); const float sg = __builtin_amdgcn_rcpf(1.0f + __builtin_amdgcn_exp2f(-x * L2E));
        const float f = lb + (1.0f - lb) * sg; kk[j] = (1.0f - lb) * (1.0f - sg); run += __builtin_amdgcn_logf(f); cs[j] = run; qv[j] = bf2f(rq[j]); }
    const float T = run, t1 = __shfl_xor(T, 16), t2 = __shfl_xor(T, 32), t3 = __shfl_xor(t1, 32);
    const float E = g == 0 ? 0.f : (g == 1 ? t1 : (g == 2 ? (t2 + t3) : (t1 + t2 + t3))), blast = (T + t1) + (t2 + t3);
    float qd[4], ki[4], ks[4];
#pragma unroll
    for (int j = 0; j < 4; ++j) { const float bj = E + cs[j]; qd[j] = qv[j] * __builtin_amdgcn_exp2f(bj); ki[j] = kk[j] * __builtin_amdgcn_exp2f(-bj); ks[j] = kk[j] * __builtin_amdgcn_exp2f(blast - bj); }
    const int colb = (16 * w + l16) * 2;
    const unsigned q01 = cvtpk(qd[0], qd[1]), q23 = cvtpk(qd[2], qd[3]), k01 = cvtpk(ki[0], ki[1]), k23 = cvtpk(ki[2], ki[3]);
    LAS unsigned char* qp = buf + SC_QD + (4 * g) * SC_RS + colb; LAS unsigned char* kp = buf + SC_KI + (4 * g) * SC_RS + colb;
    *(LAS unsigned short*)(qp) = (unsigned short)(q01 & 0xffffu); *(LAS unsigned short*)(qp + SC_RS) = (unsigned short)(q01 >> 16);
    *(LAS unsigned short*)(qp + 2 * SC_RS) = (unsigned short)(q23 & 0xffffu); *(LAS unsigned short*)(qp + 3 * SC_RS) = (unsigned short)(q23 >> 16);
    *(LAS unsigned short*)(kp) = (unsigned short)(k01 & 0xffffu); *(LAS unsigned short*)(kp + SC_RS) = (unsigned short)(k01 >> 16);
    *(LAS unsigned short*)(kp + 2 * SC_RS) = (unsigned short)(k23 & 0xffffu); *(LAS unsigned short*)(kp + 3 * SC_RS) = (unsigned short)(k23 >> 16);
    *(LAS u32x2*)(buf + SC_KST + (16 * w + l16) * 32 + 8 * g) = (u32x2){cvtpk(ks[0], ks[1]), cvtpk(ks[2], ks[3])};
    if (g == 0) *(LAS float*)(buf + SC_DEC + (16 * w + l16) * 4) = __builtin_amdgcn_exp2f(blast);
    st.vf = __builtin_bit_cast(s16x4, (u32x2){rv[0] | (rv[1] << 16), rv[2] | (rv[3] << 16)});
#pragma unroll
    for (int j = 0; j < 4; ++j) st.gv[j] = bf2f(rg[j]);
}
__device__ __forceinline__ bf16x8 cat44(const s16x4 a, const s16x4 b) { return (bf16x8){a[0], a[1], a[2], a[3], b[0], b[1], b[2], b[3]}; }
__device__ __forceinline__ void scan_mma(f32x4 (&St)[8], const ScanSt& st, f32x4& o, LAS unsigned char* buf, int w, int l16, int g) {
    const LAS unsigned char* qp = buf + SC_QD + l16 * SC_RS + 8 * g; const LAS unsigned char* kp = buf + SC_KI + l16 * SC_RS + 8 * g;
    bf16x8 qd[4], ki[4];
#pragma unroll
    for (int ks = 0; ks < 4; ++ks) { qd[ks] = cat44(*(const LAS s16x4*)(qp + 64 * ks), *(const LAS s16x4*)(qp + 64 * ks + 32)); ki[ks] = cat44(*(const LAS s16x4*)(kp + 64 * ks), *(const LAS s16x4*)(kp + 64 * ks + 32)); }
    f32x4 at = {0.f, 0.f, 0.f, 0.f};
#pragma unroll
    for (int ks = 0; ks < 4; ++ks) at = __builtin_amdgcn_mfma_f32_16x16x32_bf16(ki[ks], qd[ks], at, 0, 0, 0);
#pragma unroll
    for (int i = 0; i < 4; ++i) if (4 * g + i > l16) at[i] = 0.f;
    const s16x4 pf = __builtin_bit_cast(s16x4, (u32x2){cvtpk(at[0], at[1]), cvtpk(at[2], at[3])});
    f32x4 oo = {0.f, 0.f, 0.f, 0.f};
#pragma unroll
    for (int ks = 0; ks < 4; ++ks) { const f32x4 s0 = St[2 * ks], s1 = St[2 * ks + 1];
        const bf16x8 sb = __builtin_bit_cast(bf16x8, (u32x4){cvtpk(s0[0], s0[1]), cvtpk(s0[2], s0[3]), cvtpk(s1[0], s1[1]), cvtpk(s1[2], s1[3])});
        oo = __builtin_amdgcn_mfma_f32_16x16x32_bf16(qd[ks], sb, oo, 0, 0, 0); }
    oo = __builtin_amdgcn_mfma_f32_16x16x16bf16_1k(pf, st.vf, oo, 0, 0, 0);
#pragma unroll
    for (int kt = 0; kt < 8; ++kt) { const s16x4 kst = *(const LAS s16x4*)(buf + SC_KST + (16 * kt + l16) * 32 + 8 * g); const f32x4 d4 = *(const LAS f32x4*)(buf + SC_DEC + (16 * kt + 4 * g) * 4);
        St[kt] = __builtin_amdgcn_mfma_f32_16x16x16bf16_1k(kst, st.vf, St[kt] * d4, 0, 0, 0); }
    o = oo;
    f32x4 q2 = oo * oo;
#pragma unroll
    for (int off = 1; off < 16; off <<= 1) { q2[0] += __shfl_xor(q2[0], off); q2[1] += __shfl_xor(q2[1], off); q2[2] += __shfl_xor(q2[2], off); q2[3] += __shfl_xor(q2[3], off); }
    if (l16 == 0) *(LAS f32x4*)(buf + SC_SSQ + (w * 16 + 4 * g) * 4) = q2;
}
__device__ __forceinline__ void scan_finish(const f32x4& o, const ScanSt& st, const LAS unsigned char* buf, bf16* HIO, size_t off, float gn, int g) {
    f32x4 tot = {0.f, 0.f, 0.f, 0.f};
#pragma unroll
    for (int w8 = 0; w8 < 8; ++w8) tot += *(const LAS f32x4*)(buf + SC_SSQ + (w8 * 16 + 4 * g) * 4);
#pragma unroll
    for (int i = 0; i < 4; ++i) { const float val = o[i] * __builtin_amdgcn_rsqf(tot[i] * (1.0f / 128.0f) + EPS) * gn * st.gv[i]; HIO[off + (size_t)i * DM] = (unsigned short)(cvtpk(val, 0.f) & 0xffffu); }
}
__device__ __forceinline__ void scan_mfma_phase(const Params& p, LAS unsigned char* lds) {
    const bf16* HQ = (const bf16*)(p.ws + WS_R1); const bf16* HF = (const bf16*)(p.ws + WS_R2); bf16* HIO = (bf16*)(p.ws + WS_R3); const bf16* HG = (const bf16*)(p.ws + WS_R4);
    int tid_ = threadIdx.x; asm volatile("" : "+v"(tid_));
    const int lane = tid_ & 63, w = __builtin_amdgcn_readfirstlane(tid_ >> 6), l16 = lane & 15, g = lane >> 4;
    LAS unsigned char* buf0 = lds; LAS unsigned char* buf1 = lds + SC_BUF;
    for (int item = blockIdx.x; item < NBATCH * 8; item += gridDim.x) {
        const int b = item >> 3, h = item & 7, col = h * 128 + 16 * w + l16;
        const float lb = 1.0f / (1.0f + __expf(p.lb_logits[1024 + col] - p.lb_logits[col])), gn = p.hg_norm_g[16 * w + l16];
        f32x4 St[8];
#pragma unroll
        for (int kt = 0; kt < 8; ++kt) St[kt] = (f32x4){0.f, 0.f, 0.f, 0.f};
#define SC_OFF(c) (((c) == 0 ? (size_t)MR : (size_t)b * SEQ + (size_t)((c) - 1) * 16) + 4 * g) * DM + col
#define SC_BAR() asm volatile("s_waitcnt lgkmcnt(0)\n\ts_barrier" ::: "memory")
        const bf16* P0 = (tid_ >> 8) ? HF : HQ; const bf16* P1 = (tid_ >> 8) ? HG : (const bf16*)HIO;
#define SC_LOFF(c) ((((c) == 0 ? (size_t)MR : (size_t)b * SEQ + (size_t)((c) - 1) * 16) + ((tid_ >> 4) & 15)) * DM + h * 128 + (tid_ & 15) * 8)
#define SC_LOFFC(c) SC_LOFF(((c) < 128 ? (c) : 128))
#define SC_SLOT(c) (lds + SC_RAW + ((c) % 3) * SC_RAWSZ)
        ScanRaw rawA, rawB; ScanSt st0, st1; f32x4 oprev = {0.f, 0.f, 0.f, 0.f};
        scan_load(rawA, P0, P1, SC_LOFF(0)); scan_load(rawB, P0, P1, SC_LOFF(1));
        scan_stage(rawA, SC_SLOT(0), tid_); scan_stage(rawB, SC_SLOT(1), tid_);
        scan_load(rawB, P0, P1, SC_LOFF(2));
        SC_BAR();
        scan_gate(SC_SLOT(0), st0, buf0, lb, w, l16, g);
        SC_BAR();
        for (int i = 0; i < 130; i += 2) {
            scan_load(rawA, P0, P1, SC_LOFFC(i + 3));
            if (i >= 2) scan_finish(oprev, st1, buf1, HIO, SC_OFF(i - 1), gn, g);
            if (w < 4) { scan_gate(SC_SLOT(i + 1), st1, buf1, lb, w, l16, g); scan_mma(St, st0, oprev, buf0, w, l16, g); }
            else       { scan_mma(St, st0, oprev, buf0, w, l16, g); scan_gate(SC_SLOT(i + 1), st1, buf1, lb, w, l16, g); }
            scan_stage(rawB, SC_SLOT(i + 2), tid_);
            SC_BAR();
            scan_load(rawB, P0, P1, SC_LOFFC(i + 4));
            if (i >= 2) scan_finish(oprev, st0, buf0, HIO, SC_OFF(i), gn, g);
            if (w < 4) { scan_gate(SC_SLOT(i + 2), st0, buf0, lb, w, l16, g); scan_mma(St, st1, oprev, buf1, w, l16, g); }
            else       { scan_mma(St, st1, oprev, buf1, w, l16, g); scan_gate(SC_SLOT(i + 2), st0, buf0, lb, w, l16, g); }
            scan_stage(rawA, SC_SLOT(i + 3), tid_);
            SC_BAR();
        }
#undef SC_LOFF
#undef SC_LOFFC
#undef SC_SLOT
#undef SC_OFF
#undef SC_BAR
        __syncthreads();
    }
}

__device__ __forceinline__ int crow(int r, int hi) { return (r & 3) + 8 * (r >> 2) + 4 * hi; }
typedef short v4i16_t __attribute__((ext_vector_type(4)));
__device__ __forceinline__ s16x4 vtr(const LAS unsigned char* ptr) { return __builtin_bit_cast(s16x4, __builtin_amdgcn_ds_read_tr16_b64_v4i16((LAS v4i16_t*)ptr)); }
constexpr int KS_STRIDE = 400, VS_STRIDE = 320  , KBUF = 64 * KS_STRIDE, VBUF = 64 * VS_STRIDE, ABUF = KBUF + VBUF;
__device__ __forceinline__ void attn_phase(const Params& p, LAS unsigned char* lds) {
    const bf16* QN = (const bf16*)(p.ws + WS_R1); const bf16* QR = (const bf16*)(p.ws + WS_R2); const bf16* KN = (const bf16*)(p.ws + WS_R0); const bf16* VV = (const bf16*)(p.ws + WS_R5);
    const bf16* KPE = (const bf16*)(p.ws + WS_KPE); bf16* AO = (bf16*)(p.ws + WS_R4);
    int tid_ = threadIdx.x; asm volatile("" : "+v"(tid_));
    const int tid = tid_, lane = tid & 63, wid = tid >> 6, c = lane & 31, hi = lane >> 5;
    const float NEG = -__builtin_inff();
    const int srow = tid >> 3, ssub = tid & 7;
    const int G_ = gridDim.x, vcu = (G_ % 8 == 0) ? (int)(blockIdx.x & 7) * (G_ >> 3) + (int)(blockIdx.x >> 3) : (int)blockIdx.x;
    for (int it = vcu; it < NBATCH * 8 * 4; it += G_) {
        const int bh = it >> 2, pp = it & 3, b = bh >> 3, h = bh & 7;
        for (int half = 0; half < 2; ++half) {
            const int qblk = half ? 7 - pp : pp;
            const int tq = qblk * 256 + wid * 32 + c;
            const size_t rowq = (size_t)b * SEQ + tq;
            bf16x8 qf[12];
#pragma unroll
            for (int d = 0; d < 8; ++d) qf[d] = *(const bf16x8*)(QN + rowq * 1024 + h * 128 + d * 16 + hi * 8);
#pragma unroll
            for (int d = 0; d < 4; ++d) qf[8 + d] = *(const bf16x8*)(QR + rowq * 512 + h * 64 + d * 16 + hi * 8);
            float mrun = -1e30f, lrun = 0.f; f32x16 o[4];
#pragma unroll
            for (int d = 0; d < 4; ++d) o[d] = (f32x16){};
            const int ntiles = 4 * qblk + 5;
            u32x4 kreg[3], vreg[2];
#define LOAD_TILE(JT) do { const int jt_ = (JT); const unsigned base_ = jt_ == 0 ? (unsigned)MR : (unsigned)(b * SEQ + (jt_ - 1) * 64); const int nvalid_ = jt_ == 0 ? NMETA : 64; \
                kreg[0] = kreg[1] = kreg[2] = vreg[0] = vreg[1] = (u32x4){0u, 0u, 0u, 0u}; \
                if (srow < nvalid_) { const unsigned ko_ = (base_ + srow) * 2048u + h * 256 + ssub * 16, po_ = (base_ + srow) * 128u + ssub * 16;     \
                    kreg[0] = *(const u32x4*)((const char*)KN + ko_); kreg[1] = *(const u32x4*)((const char*)KN + ko_ + 128u); kreg[2] = *(const u32x4*)((const char*)KPE + po_); \
                    vreg[0] = *(const u32x4*)((const char*)VV + ko_); vreg[1] = *(const u32x4*)((const char*)VV + ko_ + 128u); } } while (0)
#define STORE_TILE(OFF) do { LAS unsigned char* Kd_ = lds + (OFF); LAS unsigned char* kd = Kd_ + srow * KS_STRIDE + ssub * 16; LAS unsigned char* vd = Kd_ + KBUF + srow * VS_STRIDE + ssub * 16; \
                *(LAS u32x4*)(kd) = kreg[0]; *(LAS u32x4*)(kd + 128) = kreg[1]; *(LAS u32x4*)(kd + 256) = kreg[2]; *(LAS u32x4*)(vd) = vreg[0]; *(LAS u32x4*)(vd + 128) = vreg[1]; } while (0)
            LOAD_TILE(0); STORE_TILE(0); LOAD_TILE(1);
            __syncthreads();
            int ring_cur = 0, ring_nxt = ABUF;
#pragma unroll 1
            for (int jt = 0; jt < ntiles; ++jt) {
                LAS unsigned char* Ks = lds + ring_cur; LAS unsigned char* Vs = Ks + KBUF;
                f32x16 p0 = (f32x16){}, p1 = (f32x16){};
                { const LAS unsigned char* kp = Ks + c * KS_STRIDE + hi * 16;
                  bf16x8 a0 = *(const LAS bf16x8*)(kp), a1 = *(const LAS bf16x8*)(kp + 32 * KS_STRIDE);
#pragma unroll
                  for (int d = 0; d < 12; ++d) { bf16x8 n0 = a0, n1 = a1;
                      if (d < 11) { n0 = *(const LAS bf16x8*)(kp + (d + 1) * 32); n1 = *(const LAS bf16x8*)(kp + 32 * KS_STRIDE + (d + 1) * 32); }
                      p0 = __builtin_amdgcn_mfma_f32_32x32x16_bf16(a0, qf[d], p0, 0, 0, 0); p1 = __builtin_amdgcn_mfma_f32_32x32x16_bf16(a1, qf[d], p1, 0, 0, 0);
                      a0 = n0; a1 = n1; } }
                const LAS unsigned char* vb = Vs + (4 * hi + ((lane & 15) >> 2)) * VS_STRIDE + (((lane >> 4) & 1) * 16 + 4 * (lane & 3)) * 2;
                s16x4 vlo[2][4], vhi[2][4];
#pragma unroll
                for (int s = 0; s < 4; ++s) { vlo[0][s] = vtr(vb + (16 * s) * VS_STRIDE); vhi[0][s] = vtr(vb + (16 * s + 8) * VS_STRIDE); }
                if (jt == 0) {
#pragma unroll
                    for (int r = 0; r < 16; ++r) { if (crow(r, hi) >= NMETA) p0[r] = NEG; p1[r] = NEG; }
                } else if (jt - 1 >= 4 * qblk) {
                    const int kb = 64 * (jt - 1);
#pragma unroll
                    for (int r = 0; r < 16; ++r) { const int key = kb + crow(r, hi); if (key > tq) p0[r] = NEG; if (key + 32 > tq) p1[r] = NEG; }
                }
                float rm = p0[0];
#pragma unroll
                for (int r = 1; r < 16; ++r) rm = fmaxf(rm, p0[r]);
#pragma unroll
                for (int r = 0; r < 16; ++r) rm = fmaxf(rm, p1[r]);
                rm = fmaxf(rm, __shfl_xor(rm, 32));
                const float mn = fmaxf(mrun, rm), alpha = __builtin_amdgcn_exp2f(mrun - mn); mrun = mn;
                float ps = 0.f;
#pragma unroll
                for (int r = 0; r < 16; ++r) { p0[r] = __builtin_amdgcn_exp2f(p0[r] - mn); p1[r] = __builtin_amdgcn_exp2f(p1[r] - mn); ps += p0[r] + p1[r]; }
                lrun = lrun * alpha + ps;
                if (__any(alpha != 1.0f)) {
#pragma unroll
                    for (int d = 0; d < 4; ++d) o[d] *= alpha; }
                bf16x8 pf[4];
#pragma unroll
                for (int s = 0; s < 2; ++s) {
                    u32x4 w0 = {cvtpk(p0[8 * s + 0], p0[8 * s + 1]), cvtpk(p0[8 * s + 2], p0[8 * s + 3]), cvtpk(p0[8 * s + 4], p0[8 * s + 5]), cvtpk(p0[8 * s + 6], p0[8 * s + 7])};
                    u32x4 w1 = {cvtpk(p1[8 * s + 0], p1[8 * s + 1]), cvtpk(p1[8 * s + 2], p1[8 * s + 3]), cvtpk(p1[8 * s + 4], p1[8 * s + 5]), cvtpk(p1[8 * s + 6], p1[8 * s + 7])};
                    pf[s] = __builtin_bit_cast(bf16x8, w0); pf[2 + s] = __builtin_bit_cast(bf16x8, w1); }
                __builtin_amdgcn_sched_barrier(0);
                if (jt + 1 < ntiles) { STORE_TILE(ring_nxt); if (jt + 2 < ntiles) LOAD_TILE(jt + 2); }
                __builtin_amdgcn_sched_barrier(0);
#pragma unroll
                for (int d = 0; d < 4; ++d) {
                    if (d < 3) {
#pragma unroll
                        for (int s = 0; s < 4; ++s) { vlo[(d + 1) & 1][s] = vtr(vb + (16 * s) * VS_STRIDE + (d + 1) * 64); vhi[(d + 1) & 1][s] = vtr(vb + (16 * s + 8) * VS_STRIDE + (d + 1) * 64); } }
#pragma unroll
                    for (int s = 0; s < 4; ++s) {
                        const s16x4 lo = vlo[d & 1][s], hh = vhi[d & 1][s];
                        const bf16x8 vf = {lo[0], lo[1], lo[2], lo[3], hh[0], hh[1], hh[2], hh[3]};
                        o[d] = __builtin_amdgcn_mfma_f32_32x32x16_bf16(vf, pf[s], o[d], 0, 0, 0); } }
                __syncthreads();
                ring_cur = ring_nxt; ring_nxt = (ring_nxt == 2 * ABUF) ? 0 : ring_nxt + ABUF;
            }
#undef STORE_TILE
            const float ltot = lrun + __shfl_xor(lrun, 32), inv = 1.0f / ltot;
            bf16* orow = AO + rowq * 1024 + h * 128;
#pragma unroll
            for (int d = 0; d < 4; ++d)
#pragma unroll
                for (int g = 0; g < 4; ++g)
                    *(u32x2*)(orow + d * 32 + 8 * g + 4 * hi) = (u32x2){cvtpk(o[d][4 * g] * inv, o[d][4 * g + 1] * inv), cvtpk(o[d][4 * g + 2] * inv, o[d][4 * g + 3] * inv)};
        }
    }
}

__device__ __forceinline__ void rows1_phase(const Params& p) {
    const bf16* Y = (const bf16*)(p.ws + WS_R0); const f32x4* part = (const f32x4*)(p.ws + PART_1); bf16* U2 = (bf16*)(p.ws + WS_R1);
    int tid_ = threadIdx.x; asm volatile("" : "+v"(tid_));
    const int lane = tid_ & 63, gw = blockIdx.x * NWAVES + (tid_ >> 6), NGW = gridDim.x * NWAVES;
    f32x4 gp[4], g2[4];
#pragma unroll
    for (int j = 0; j < 4; ++j) { gp[j] = *(const f32x4*)(p.mix_post_g + 4 * lane + 256 * j); g2[j] = *(const f32x4*)(p.ffn_pre_g + 4 * lane + 256 * j); }
    for (int r = gw; r < MR; r += 2 * NGW) {
        u32x2 y[2][4]; f32x4 xv[2][4], qp[2][4];
#pragma unroll
        for (int q = 0; q < 2; ++q) { const size_t rr = (size_t)(r + q * NGW < MR ? r + q * NGW : r);
#pragma unroll
            for (int j = 0; j < 4; ++j) { y[q][j] = *((const u32x2*)(Y + rr * DM) + lane + 64 * j); xv[q][j] = *(const f32x4*)(p.x + rr * DM + 4 * lane + 256 * j); qp[q][j] = part[rr * 4 + j]; } }
#pragma unroll
        for (int q = 0; q < 2; ++q) { const int rq = r + q * NGW; if (rq >= MR) break; const size_t rr = (size_t)rq;
            const f32x4 qs = (qp[q][0] + qp[q][1]) + (qp[q][2] + qp[q][3]);
            const float rs = __builtin_amdgcn_rsqf(((qs[0] + qs[1]) + (qs[2] + qs[3])) * (1.0f / DM) + EPS);
            f32x4 hv[4]; float s = 0.f;
#pragma unroll
            for (int j = 0; j < 4; ++j) { const f32x4 yv = {bf_lo(y[q][j].x), bf_hi(y[q][j].x), bf_lo(y[q][j].y), bf_hi(y[q][j].y)};
                hv[j] = xv[q][j] + yv * rs * gp[j]; *((u32x2*)(p.out + rr * DM) + lane + 64 * j) = (u32x2){cvtpk(hv[j][0], hv[j][1]), cvtpk(hv[j][2], hv[j][3])};
                s += (hv[j][0] * hv[j][0] + hv[j][1] * hv[j][1]) + (hv[j][2] * hv[j][2] + hv[j][3] * hv[j][3]); }
            const float rs2 = __builtin_amdgcn_rsqf(wave_sum(s) * (1.0f / DM) + EPS);
#pragma unroll
            for (int j = 0; j < 4; ++j) { const f32x4 w = hv[j] * rs2 * g2[j]; *((u32x2*)(U2 + rr * DM) + lane + 64 * j) = (u32x2){cvtpk(w[0], w[1]), cvtpk(w[2], w[3])}; } }
    }
}
__device__ __forceinline__ void rows2_phase(const Params& p) {
    const bf16* Y = (const bf16*)(p.ws + WS_R0); const f32x4* part = (const f32x4*)(p.ws + PART_2);
    int tid_ = threadIdx.x; asm volatile("" : "+v"(tid_));
    const int lane = tid_ & 63, gw = blockIdx.x * NWAVES + (tid_ >> 6), NGW = gridDim.x * NWAVES;
    f32x4 gp[4];
#pragma unroll
    for (int j = 0; j < 4; ++j) gp[j] = *(const f32x4*)(p.ffn_post_g + 4 * lane + 256 * j);
    for (int r = gw; r < MR; r += 2 * NGW) {
        u32x2 y[2][4], hb[2][4]; f32x4 qp[2][4];
#pragma unroll
        for (int q = 0; q < 2; ++q) { const size_t rr = (size_t)(r + q * NGW < MR ? r + q * NGW : r);
#pragma unroll
            for (int j = 0; j < 4; ++j) { y[q][j] = *((const u32x2*)(Y + rr * DM) + lane + 64 * j); hb[q][j] = *((const u32x2*)(p.out + rr * DM) + lane + 64 * j); qp[q][j] = part[rr * 4 + j]; } }
        asm volatile("s_waitcnt vmcnt(0)" ::: "memory");
#pragma unroll
        for (int q = 0; q < 2; ++q) { const int rq = r + q * NGW; if (rq >= MR) break; const size_t rr = (size_t)rq;
            const f32x4 qs = (qp[q][0] + qp[q][1]) + (qp[q][2] + qp[q][3]);
            const float rs = __builtin_amdgcn_rsqf(((qs[0] + qs[1]) + (qs[2] + qs[3])) * (1.0f / DM) + EPS);
#pragma unroll
            for (int j = 0; j < 4; ++j) { const f32x4 yv = {bf_lo(y[q][j].x), bf_hi(y[q][j].x), bf_lo(y[q][j].y), bf_hi(y[q][j].y)};
                const f32x4 h1 = {bf_lo(hb[q][j].x), bf_hi(hb[q][j].x), bf_lo(hb[q][j].y), bf_hi(hb[q][j].y)};
                *(f32x4*)(p.out + rr * DM + 4 * lane + 256 * j) = h1 + yv * rs * gp[j]; } }
    }
}

#define XB_TMO      128
#define XB_XCNT(j)  (256  + 64 * (j))
#define XB_XSUB(j)  (1280 + 64 * (j))
#define XB_XGEN(j)  (2304 + 64 * (j))
#define XB_TOP      3328
#define XB_TOPGEN   3392
#define XCD_BAR_WORDS 3456
#define XB_SPIN_CAP (1u << 18)

__device__ __forceinline__ unsigned xb_ld(unsigned* p)              { return __hip_atomic_load(p, __ATOMIC_RELAXED, __HIP_MEMORY_SCOPE_AGENT); }
__device__ __forceinline__ unsigned xb_add(unsigned* p, unsigned v) { return __hip_atomic_fetch_add(p, v, __ATOMIC_RELAXED, __HIP_MEMORY_SCOPE_AGENT); }
__device__ __forceinline__ unsigned xb_xcc_id() { return (unsigned)__builtin_amdgcn_s_getreg((3 << 11) | 20) & 0xFu; }
#define XB_SPIN(cond, bar) do { unsigned _sp = 0; while (cond) { __builtin_amdgcn_s_sleep(1); \
    if ((++_sp & 255u) == 0u) { if (xb_ld(&(bar)[XB_TMO])) break; if (_sp > XB_SPIN_CAP) { atomicAdd(&(bar)[XB_TMO], 1u); break; } } } } while (0)

struct XcdBarrier {
    unsigned* bar; unsigned x;
    volatile LAS unsigned* st;
};

__device__ __forceinline__ XcdBarrier xcd_barrier_post(unsigned* bar, volatile LAS unsigned* st) {
    XcdBarrier b; b.bar = bar; b.x = xb_xcc_id(); b.st = st;
    if (threadIdx.x == 0) (void)xb_add(&bar[XB_XCNT(b.x)], 1u);
    return b;
}
__device__ __forceinline__ void xcd_barrier_complete(unsigned* bar, unsigned x, unsigned& nloc, unsigned& nx) {
    const unsigned G = gridDim.x * gridDim.y * gridDim.z;
    unsigned sum, cnt, mine, sp = 0u;
    for (;;) {
        sum = 0u; cnt = 0u; mine = 0u;
#pragma unroll
        for (unsigned j = 0; j < 16; ++j) { const unsigned c = xb_ld(&bar[XB_XCNT(j)]); sum += c; cnt += (c > 0u) ? 1u : 0u; mine = (j == x) ? c : mine; }
        if (sum == G) break;
        __builtin_amdgcn_s_sleep(1);
        if ((++sp & 255u) == 0u) { if (xb_ld(&bar[XB_TMO])) break; if (sp > XB_SPIN_CAP) { atomicAdd(&bar[XB_TMO], 1u); break; } }
    }
    nloc = mine > 0u ? mine : 1u; nx = cnt > 0u ? cnt : 1u;
}

__device__ __forceinline__ void xcd_barrier(const XcdBarrier& b) {
    asm volatile("s_waitcnt vmcnt(0)" ::: "memory");
    __syncthreads();
    if (threadIdx.x == 0) {
        unsigned* bar = b.bar;
        __builtin_amdgcn_s_waitcnt(0);
        unsigned nloc = b.st[0], nx = b.st[1];
        if (nloc == 0u) { xcd_barrier_complete(bar, b.x, nloc, nx); b.st[0] = nloc; b.st[1] = nx; }
        const unsigned old = xb_add(&bar[XB_XSUB(b.x)], 1u);
        const unsigned gen = old / nloc;
        if (old + 1u == (gen + 1u) * nloc) {
            __builtin_amdgcn_fence(__ATOMIC_RELEASE, "agent");
            asm volatile("s_waitcnt vmcnt(0)" ::: "memory");
            const unsigned og = xb_add(&bar[XB_TOP], 1u);
            const unsigned tg = og / nx;
            if (og + 1u == (tg + 1u) * nx) xb_add(&bar[XB_TOPGEN], 1u);
            else XB_SPIN(xb_ld(&bar[XB_TOPGEN]) == tg, bar);
            __builtin_amdgcn_fence(__ATOMIC_ACQUIRE, "agent");
            xb_add(&bar[XB_XGEN(b.x)], 1u);
            asm volatile("s_waitcnt vmcnt(0)" ::: "memory");
        } else {
            XB_SPIN(xb_ld(&bar[XB_XGEN(b.x)]) == gen, bar);
            __builtin_amdgcn_fence(__ATOMIC_ACQUIRE, "agent");
            asm volatile("s_waitcnt vmcnt(0)" ::: "memory");
        }
    }
    __syncthreads();
}

#ifndef PH_LAST
#define PH_LAST 99
#endif
__global__ void __launch_bounds__(NTHREADS, 2) fwd_megakernel(Params p) {
    extern __shared__ __attribute__((aligned(16))) unsigned char lds_raw[];
    LAS unsigned char* lds = (LAS unsigned char*)lds_raw;
    cg::grid_group grid = cg::this_grid();
    for (int u = threadIdx.x; u < 64; u += NTHREADS) ((LAS unsigned*)(lds + XB_LDS_OFF))[u] = 0u;
    __syncthreads();
    const XcdBarrier xbar = xcd_barrier_post((unsigned*)(p.ws + WS_BAR), (volatile LAS unsigned*)(lds + XB_LDS_OFF));
    if (p.ws == nullptr) grid.sync();
#define GRID_SYNC() xcd_barrier(xbar)
    unsigned char* ws = p.ws; const int G = gridDim.x, bx = blockIdx.x;
    const float* ropecs = (const float*)(ws + WS_ROPE);
    typedef pg8::bf16_t wb;
    p0_prologue(p, lds);
    GRID_SYNC();
    { pg8::Gemm g{(const wb*)(ws + WS_R0), (const wb*)(ws + W_IN), MP, N_IN, DM, nullptr, nullptr}; pg8::StaticOrder S; S.init(MP, N_IN, G, bx);
      pg8::EpiInProj E{(wb*)(ws + WS_R1), (wb*)(ws + WS_R2), (wb*)(ws + WS_R3), (wb*)(ws + WS_R4), (wb*)(ws + WS_CQ), (wb*)(ws + WS_CKV), (wb*)p.out, (wb*)(ws + WS_KPE), (float*)(ws + PART_Q), (float*)(ws + PART_KV), p.b_gate, ropecs};
      pg8::gemm_phase<pg8::EpiInProj, pg8::StaticOrder, true, true>(lds, g, S, E); }
    GRID_SYNC();
#ifdef SCAN_NAIVE
    scan_phase(p, lds);
#else
    scan_mfma_phase(p, lds);
#endif
    { pg8::Gemm g{(const wb*)(ws + WS_CKV), (const wb*)(ws + W_KVB), MP, 2048, 256, nullptr, nullptr}; pg8::StaticOrder S; S.init(MP, 2048, G, bx);
      pg8::EpiKV E{(wb*)(ws + WS_R0), (wb*)(ws + WS_R5), (const pg8::f32x4*)(ws + PART_KV)};
      pg8::gemm_phase<pg8::EpiKV, pg8::StaticOrder, true, true>(lds, g, S, E); }
    GRID_SYNC();
    { pg8::Gemm g{(const wb*)(ws + WS_CQ), (const wb*)(ws + W_QB), MR, 1536, 256, nullptr, nullptr}; pg8::StaticOrder S; S.init(MR, 1536, G, bx);
      pg8::EpiQ E{ws, 0.07216878364870322f * 1.4426950408889634f};
      pg8::gemm_phase<pg8::EpiQ, pg8::StaticOrder, true, true>(lds, g, S, E); }
    GRID_SYNC();
    attn_phase(p, lds);
    GRID_SYNC();
    { pg8::Gemm g{(const wb*)(ws + WS_R3), (const wb*)(ws + W_HGO), MR, DM, DM, (const wb*)(ws + WS_R4), (const wb*)(ws + W_MLAO)}; pg8::PairOrder S; S.so.init(MR, DM, G, bx);
      pg8::EpiMix E{(const wb*)p.out, (wb*)(ws + WS_R1), (wb*)(ws + WS_R2)};
      pg8::gemm_phase<pg8::EpiMix, pg8::PairOrder, true, true>(lds, g, S, E); }
    GRID_SYNC();
    { pg8::Gemm g{(const wb*)(ws + WS_R2), (const wb*)(ws + W_OUT), MR, DM, DM, nullptr, nullptr}; pg8::StaticOrder S; S.init(MR, DM, G, bx);
      pg8::EpiYSsq E{(wb*)(ws + WS_R0), (float*)(ws + PART_1)};
      pg8::gemm_phase<pg8::EpiYSsq, pg8::StaticOrder, true, true>(lds, g, S, E); }
    GRID_SYNC();
    rows1_phase(p);
    GRID_SYNC();
    { pg8::Gemm g{(const wb*)(ws + WS_R1), (const wb*)(ws + W_FIN), MR, 2 * FFH, DM, nullptr, nullptr}; pg8::StaticOrder S; S.init(MR, 2 * FFH, G, bx);
      pg8::EpiSwiglu E{(wb*)(ws + WS_R2), FFH};
      pg8::gemm_phase<pg8::EpiSwiglu, pg8::StaticOrder, true, true>(lds, g, S, E); }
    GRID_SYNC();
    { pg8::Gemm g{(const wb*)(ws + WS_R2), (const wb*)(ws + W_FOUT), MR, DM, FFH, nullptr, nullptr}; pg8::StaticOrder S; S.init(MR, DM, G, bx);
      pg8::EpiYSsq E{(wb*)(ws + WS_R0), (float*)(ws + PART_2)};
      pg8::gemm_phase<pg8::EpiYSsq, pg8::StaticOrder, true, true>(lds, g, S, E); }
    GRID_SYNC();
    rows2_phase(p);
}

extern "C" void kernel_launch(void* const* d_in, const int* in_sizes, int n_in, void* d_out, int out_size, void* d_ws, size_t ws_size, hipStream_t stream) {
    static int grid = 0;
    if (grid == 0) {
        if (n_in != 19 || out_size != MR * DM || ws_size < WS_END) { fprintf(stderr, "kernel_launch: unexpected shapes (n_in %d, out %d, ws %zu < %zu)\n", n_in, out_size, ws_size, (size_t)WS_END); grid = -1; return; }
        int dev = 0, cus = 0, per_cu = 0;
        hipGetDevice(&dev); hipDeviceGetAttribute(&cus, hipDeviceAttributeMultiprocessorCount, dev);
        if (hipFuncSetAttribute((const void*)fwd_megakernel, hipFuncAttributeMaxDynamicSharedMemorySize, LDS_BYTES) != hipSuccess) { fprintf(stderr, "kernel_launch: hipFuncSetAttribute failed\n"); grid = -1; return; }
        if (hipOccupancyMaxActiveBlocksPerMultiprocessor(&per_cu, (const void*)fwd_megakernel, NTHREADS, LDS_BYTES) != hipSuccess || per_cu < 1) { fprintf(stderr, "kernel_launch: occupancy query gave %d\n", per_cu); per_cu = 1; }
        (void)hipGetLastError();
        grid = cus * per_cu;
    }
    if (grid < 0) return;
    if (hipMemsetAsync((char*)d_ws + WS_BAR, 0, WS_BAR_BYTES, stream) != hipSuccess) { fprintf(stderr, "kernel_launch: hipMemsetAsync failed\n"); return; }
    Params p{};
    const float** f = (const float**)&p;
    for (int i = 0; i < 19; ++i) f[i] = (const float*)d_in[i];
    p.out = (float*)d_out; p.ws = (unsigned char*)d_ws;
    void* args[] = {&p};
    hipError_t e = hipLaunchCooperativeKernel((const void*)fwd_megakernel, dim3(grid), dim3(NTHREADS), args, LDS_BYTES, stream);
    if (e != hipSuccess) fprintf(stderr, "cooperative launch failed: %s (grid %d)\n", hipGetErrorString(e), grid);
}
```

```cpp
#include <hip/hip_runtime.h>
#include <hip/hip_cooperative_groups.h>
#include <cstdio>
#include <cstdint>
namespace cg = cooperative_groups;
#define LAS __attribute__((address_space(3)))
typedef unsigned short bf16;
typedef float f32x4 __attribute__((ext_vector_type(4)));
typedef float f32x16 __attribute__((ext_vector_type(16)));
typedef short bf16x8 __attribute__((ext_vector_type(8)));
typedef short s16x4 __attribute__((ext_vector_type(4)));
typedef unsigned u32x4 __attribute__((ext_vector_type(4)));
typedef unsigned u32x2 __attribute__((ext_vector_type(2)));
constexpr int DM = 1024, NBATCH = 32, SEQ = 2048, MR = NBATCH * SEQ, NMETA = 16, MP = MR + 256;
constexpr int FFH = 2816, N_IN = 6912, NWAVES = 8, NTHREADS = 512;
constexpr float EPS = 1e-6f;
constexpr size_t MiB = 1u << 20;
constexpr size_t WS_SSQ = 0;
constexpr size_t WS_ROPE = 2 * MiB;
constexpr size_t WS_W = 4 * MiB;
constexpr size_t W_IN = WS_W, W_FIN = W_IN + (size_t)N_IN * DM * 2, W_FOUT = W_FIN + (size_t)2 * FFH * DM * 2, W_HGO = W_FOUT + (size_t)DM * FFH * 2,
                 W_MLAO = W_HGO + 2 * MiB, W_OUT = W_MLAO + 2 * MiB, W_QB = W_OUT + 2 * MiB, W_KVB = W_QB + (size_t)1536 * 256 * 2, W_END = W_KVB + (size_t)2048 * 256 * 2;
static_assert(W_END <= 48 * MiB, "weights");
constexpr size_t RSZ = 129 * MiB;
constexpr size_t WS_R0 = 48 * MiB, WS_R1 = WS_R0 + RSZ, WS_R2 = WS_R1 + RSZ, WS_R3 = WS_R2 + RSZ, WS_R4 = WS_R3 + RSZ, WS_R5 = WS_R4 + RSZ;
constexpr size_t WS_CQ = WS_R5 + RSZ, WS_CKV = WS_CQ + 33 * MiB, WS_KPE = WS_CKV + 33 * MiB, WS_PART = WS_KPE + 9 * MiB, WS_END = WS_PART + 12 * MiB;
constexpr size_t PART_Q = WS_PART, PART_KV = WS_PART + 2 * MiB, PART_1 = WS_PART + 4 * MiB, PART_2 = WS_PART + 8 * MiB;
static_assert((size_t)MP * DM * 2 <= RSZ && (size_t)MP * 256 * 2 <= 33 * MiB && (size_t)MP * 64 * 2 <= 9 * MiB && (size_t)MR * FFH * 2 <= 3 * RSZ, "ws map");
constexpr int LDS_BYTES = 147456, XB_LDS_OFF = 131072 + 1024;
constexpr size_t WS_BAR = WS_SSQ + 1536 * 1024, WS_BAR_BYTES = 16384;

namespace pg8 {
#define PG8_LAS __attribute__((address_space(3)))
typedef unsigned short bf16_t;
typedef short bf16x8 __attribute__((ext_vector_type(8)));
typedef float f32x4 __attribute__((ext_vector_type(4)));
typedef unsigned u32x4 __attribute__((ext_vector_type(4)));
constexpr int BM = 256, BK = 64, HALF = 128, HTB = HALF * BK * 2  , STAGE_BYTES = 8 * HTB, NXCD = 8, WGM = 8;

__host__ __device__ __forceinline__ int lds_byte(int r, int c) { const int st = (r >> 4) * 2 + (c >> 5), rr = r & 15, cc = c & 31, ob = rr * 64 + cc * 2; return st * 1024 + (ob ^ (((ob >> 9) & 1) << 5)); }
__host__ __device__ __forceinline__ void stage_rc(int b, int& R, int& C) { const int st = b / 1024, sb = b % 1024, swz = sb ^ (((sb >> 9) & 1) << 5); R = (st >> 1) * 16 + swz / 64; C = (st & 1) * 32 + (swz % 64) / 2; }
__host__ __device__ __forceinline__ int perm32(int rho) { const int n = rho >> 4, i = rho & 15; return 8 * (i >> 2) + 4 * n + (i & 3); }

struct Unit { int pm, pn, sel; };
struct Gemm { const bf16_t* A; const bf16_t* Bt; int M, N, K; const bf16_t* A2; const bf16_t* Bt2; };

struct StaticOrder {
    int nM, nN, nwg, G, c;
    __host__ __device__ void init(int M, int N, int G_, int c_) { nM = M / BM; nN = N / BM; nwg = nM * nN; G = G_; c = c_; }
    __host__ __device__ bool next(int i, Unit& u) const {
        const long L = (long)i * G + c; if (L >= nwg) return false;
        int wgid = (int)L; { const int q = nwg / NXCD, r = nwg % NXCD, xcd = wgid % NXCD, off = wgid / NXCD; wgid = (xcd < r ? xcd * (q + 1) : r * (q + 1) + (xcd - r) * q) + off; }
        const int nig = WGM * nN, gid = wgid / nig, fm = gid * WGM, gsz = (nM - fm) < WGM ? (nM - fm) : WGM;
        u.pm = fm + ((wgid % nig) % gsz); u.pn = (wgid % nig) / gsz; u.sel = 0; return true;
    }
    __device__ __forceinline__ void a_ready(const Unit&) const {}
    __device__ __forceinline__ void done(const Unit&) const {}
};

typedef float cvt_f32x2 __attribute__((ext_vector_type(2))); typedef __bf16 cvt_bf16x2 __attribute__((ext_vector_type(2)));
__device__ __forceinline__ unsigned cvt_pk_bf16(float lo, float hi) { const cvt_f32x2 v = {lo, hi}; const cvt_bf16x2 b = __builtin_convertvector(v, cvt_bf16x2); return __builtin_bit_cast(unsigned, b); }
__device__ __forceinline__ u32x4 pack8(const f32x4 a, const f32x4 b) { u32x4 w; w.x = cvt_pk_bf16(a[0], a[1]); w.y = cvt_pk_bf16(a[2], a[3]); w.z = cvt_pk_bf16(b[0], b[1]); w.w = cvt_pk_bf16(b[2], b[3]); return w; }
__device__ __forceinline__ void unpack8(const u32x4 w, f32x4& a, f32x4& b) {
    a[0] = __uint_as_float(w.x << 16); a[1] = __uint_as_float(w.x & 0xffff0000u); a[2] = __uint_as_float(w.y << 16); a[3] = __uint_as_float(w.y & 0xffff0000u);
    b[0] = __uint_as_float(w.z << 16); b[1] = __uint_as_float(w.z & 0xffff0000u); b[2] = __uint_as_float(w.w << 16); b[3] = __uint_as_float(w.w & 0xffff0000u); }
__device__ __forceinline__ float sigm(float x) { return __builtin_amdgcn_rcpf(1.0f + __builtin_amdgcn_exp2f(x * -1.4426950408889634f)); }
__device__ __forceinline__ float sigm_new(float x) { return __builtin_amdgcn_rcpf(1.0f + __builtin_amdgcn_exp2f(x * -1.4426950408889634f)); }
__device__ __forceinline__ f32x4 sigm4_new(const f32x4 v) { f32x4 o; o[0] = sigm_new(v[0]); o[1] = sigm_new(v[1]); o[2] = sigm_new(v[2]); o[3] = sigm_new(v[3]); return o; }
__device__ __forceinline__ f32x4 silu4_new(const f32x4 v) { return v * sigm4_new(v); }
__device__ __forceinline__ f32x4 sigm4(const f32x4 v) { f32x4 o; o[0] = sigm(v[0]); o[1] = sigm(v[1]); o[2] = sigm(v[2]); o[3] = sigm(v[3]); return o; }
__device__ __forceinline__ f32x4 silu4(const f32x4 v) { return v * sigm4(v); }
constexpr int EP_MR = 65536;
constexpr float EP_EPS = 1e-6f;
__device__ __forceinline__ int pos_of_row(int r) { return r < EP_MR ? 16 + (r & 2047) : ((r - EP_MR) < 16 ? (r - EP_MR) : 0); }
__device__ __forceinline__ void rope4(f32x4& a, f32x4& b, const float* cs4) {
    const f32x4 t0 = ((const f32x4*)cs4)[0], t1 = ((const f32x4*)cs4)[1];
    const f32x4 c = {t0[0], t0[2], t1[0], t1[2]}, s = {t0[1], t0[3], t1[1], t1[3]};
    const f32x4 na = a * c - b * s, nb = b * c + a * s; a = na; b = nb;
}
__device__ __forceinline__ void rope8(f32x4& a0, f32x4& a1, f32x4& b0, f32x4& b1, const float* cs, int pos, int i0) {
    const float* t = cs + ((size_t)pos * 32 + i0) * 2;
    rope4(a0, b0, t); asm volatile("" ::: "memory"); rope4(a1, b1, t + 8);
}
#define EPI_ROWLOOP _Pragma("unroll") for (int ai = 0; ai < 2; ++ai) _Pragma("unroll") for (int m = 0; m < 4; ++m)

struct EpiInProj {
    static constexpr bool PERM = true, AFTER_DRAIN = false;
    bf16_t *HQ, *HF, *HI, *HG, *CQ, *CKV, *GATES, *KPE; float* ssq_q; float* ssq_kv; const float* b_gate; const float* ropecs;
    __device__ __forceinline__ void operator()(const f32x4 (&acc)[2][2][4][2], const Unit& u, int wr, int wc, int fr, int fq) const {
        const int pn = u.pn, row0 = u.pm * BM + wr * 64 + fr, cl = wc * 32 + 8 * fq;
        if (pn < 16) {
            bf16_t* base = pn < 4 ? HQ : pn < 8 ? HF : pn < 12 ? HI : HG; const bool act = (pn < 4) || (pn >= 12);
            const int col0 = (pn & 3) * 256 + cl;
            EPI_ROWLOOP { bf16_t* rowp = base + (size_t)(row0 + ai * HALF + m * 16) * 1024 + col0;
#pragma unroll
                for (int bj = 0; bj < 2; ++bj) { f32x4 v0 = acc[ai][bj][m][0], v1 = acc[ai][bj][m][1]; if (act) { v0 = silu4(v0); v1 = silu4(v1); }
                    *(u32x4*)(rowp + bj * HALF) = pack8(v0, v1); } }
        } else if (pn < 18) {
            bf16_t* base = pn == 16 ? CQ : CKV; float* part = pn == 16 ? ssq_q : ssq_kv;
            EPI_ROWLOOP { const int r = row0 + ai * HALF + m * 16; bf16_t* rowp = base + (size_t)r * 256 + cl; float s = 0.f;
#pragma unroll
                for (int bj = 0; bj < 2; ++bj) { const f32x4 v0 = acc[ai][bj][m][0], v1 = acc[ai][bj][m][1];
                    s += (v0[0] * v0[0] + v0[1] * v0[1]) + (v0[2] * v0[2] + v0[3] * v0[3]) + (v1[0] * v1[0] + v1[1] * v1[1]) + (v1[2] * v1[2] + v1[3] * v1[3]);
                    *(u32x4*)(rowp + bj * HALF) = pack8(v0, v1); }
                s += __shfl_xor(s, 16); s += __shfl_xor(s, 32);
                if (fq == 0) part[(size_t)r * 4 + wc] = s; }
        } else if (pn < 26) {
            if (u.pm * BM >= EP_MR) return;
            const int gc = (pn - 18) * 256 + cl;
            f32x4 bv[2][2];
#pragma unroll
            for (int bj = 0; bj < 2; ++bj) { bv[bj][0] = *(const f32x4*)(b_gate + gc + bj * HALF); bv[bj][1] = *(const f32x4*)(b_gate + gc + bj * HALF + 4); }
            EPI_ROWLOOP { bf16_t* rowp = GATES + (size_t)(row0 + ai * HALF + m * 16) * 2048 + gc;
#pragma unroll
                for (int bj = 0; bj < 2; ++bj) *(u32x4*)(rowp + bj * HALF) = pack8(sigm4(acc[ai][bj][m][0] + bv[bj][0]), sigm4(acc[ai][bj][m][1] + bv[bj][1])); }
        } else {
            if (wc != 0) return;
            EPI_ROWLOOP { const int r = row0 + ai * HALF + m * 16;
                f32x4 a0 = acc[ai][0][m][0], a1 = acc[ai][0][m][1], b0 = acc[ai][1][m][0], b1 = acc[ai][1][m][1];
                rope8(a0, a1, b0, b1, ropecs, pos_of_row(r), 8 * fq);
                bf16_t* rowp = KPE + (size_t)r * 64 + 8 * fq;
                *(u32x4*)(rowp) = pack8(a0, a1); *(u32x4*)(rowp + 32) = pack8(b0, b1); }
        }
    }
};
struct EpiQ {
    static constexpr bool PERM = true, AFTER_DRAIN = false;
    unsigned char* ws; float qscale;
    __device__ __forceinline__ void operator()(const f32x4 (&acc)[2][2][4][2], const Unit& u, int wr, int wc, int fr, int fq) const {
        typedef unsigned u32x2 __attribute__((ext_vector_type(2)));
        const int pn = u.pn, row0 = u.pm * BM + wr * 64 + fr, cl = wc * 32 + 8 * fq;
        const f32x4* part = (const f32x4*)(ws + PART_Q);
        if (pn < 4) {
            bf16_t* QN = (bf16_t*)(ws + WS_R1);
            EPI_ROWLOOP { const int r = row0 + ai * HALF + m * 16; const f32x4 pq = part[r]; const float rs = __builtin_amdgcn_rsqf(((pq[0] + pq[1]) + (pq[2] + pq[3])) * (1.0f / 256.0f) + EP_EPS) * qscale;
                bf16_t* rowp = QN + (size_t)r * 1024 + pn * 256 + cl;
#pragma unroll
                for (int bj = 0; bj < 2; ++bj) *(u32x4*)(rowp + bj * HALF) = pack8(acc[ai][bj][m][0] * rs, acc[ai][bj][m][1] * rs); }
        } else {
            bf16_t* QR = (bf16_t*)(ws + WS_R2); const float* ropecs = (const float*)(ws + WS_ROPE);
            EPI_ROWLOOP { const int r = row0 + ai * HALF + m * 16; const f32x4 pq = part[r]; const float rs = __builtin_amdgcn_rsqf(((pq[0] + pq[1]) + (pq[2] + pq[3])) * (1.0f / 256.0f) + EP_EPS) * qscale;
                const float* t = ropecs + ((size_t)pos_of_row(r) * 32 + 8 * fq) * 2;
                bf16_t* rowp = QR + (size_t)r * 512 + (4 * (pn - 4) + wc) * 64 + 8 * fq;
#pragma unroll
                for (int n = 0; n < 2; ++n) { f32x4 a = acc[ai][0][m][n], b = acc[ai][1][m][n]; rope4(a, b, t + 8 * n); a = a * rs; b = b * rs;
                    *(u32x2*)(rowp + 4 * n) = (u32x2){cvt_pk_bf16(a[0], a[1]), cvt_pk_bf16(a[2], a[3])}; *(u32x2*)(rowp + 32 + 4 * n) = (u32x2){cvt_pk_bf16(b[0], b[1]), cvt_pk_bf16(b[2], b[3])};
                    asm volatile("" ::: "memory"); } }
        }
    }
};
struct EpiKV {
    static constexpr bool PERM = true, AFTER_DRAIN = false;
    bf16_t *KN, *VV; const f32x4* part;
    __device__ __forceinline__ void operator()(const f32x4 (&acc)[2][2][4][2], const Unit& u, int wr, int wc, int fr, int fq) const {
        const int pn = u.pn, row0 = u.pm * BM + wr * 64 + fr, cl = wc * 32 + 8 * fq;
        bf16_t* base = pn < 4 ? KN : VV;
        EPI_ROWLOOP { const int r = row0 + ai * HALF + m * 16; const f32x4 pq = part[r]; const float rs = __builtin_amdgcn_rsqf(((pq[0] + pq[1]) + (pq[2] + pq[3])) * (1.0f / 256.0f) + EP_EPS);
            bf16_t* rowp = base + (size_t)r * 1024 + (pn & 3) * 256 + cl;
#pragma unroll
            for (int bj = 0; bj < 2; ++bj) *(u32x4*)(rowp + bj * HALF) = pack8(acc[ai][bj][m][0] * rs, acc[ai][bj][m][1] * rs); }
    }
};
struct EpiMix {
    static constexpr bool PERM = true, AFTER_DRAIN = false;
    const bf16_t* GATES; bf16_t* T; bf16_t* MIX;
    __device__ __forceinline__ void operator()(const f32x4 (&acc)[2][2][4][2], const Unit& u, int wr, int wc, int fr, int fq) const {
        const int row0 = u.pm * BM + wr * 64 + fr, c0 = u.pn * 256 + wc * 32 + 8 * fq;
        EPI_ROWLOOP { const int r = row0 + ai * HALF + m * 16;
#pragma unroll
            for (int bj = 0; bj < 2; ++bj) { const int c = c0 + bj * HALF; f32x4 g0, g1; unpack8(*(const u32x4*)(GATES + (size_t)r * 2048 + (u.sel ? 1024 : 0) + c), g0, g1);
                f32x4 v0 = acc[ai][bj][m][0] * g0, v1 = acc[ai][bj][m][1] * g1;
                if (u.sel) { f32x4 t0, t1; unpack8(*(const u32x4*)(T + (size_t)r * 1024 + c), t0, t1); v0 += t0; v1 += t1; *(u32x4*)(MIX + (size_t)r * 1024 + c) = pack8(v0, v1); }
                else *(u32x4*)(T + (size_t)r * 1024 + c) = pack8(v0, v1); } }
    }
};
struct EpiYSsq {
    static constexpr bool PERM = true, AFTER_DRAIN = false;
    bf16_t* Y; float* part;
    __device__ __forceinline__ void operator()(const f32x4 (&acc)[2][2][4][2], const Unit& u, int wr, int wc, int fr, int fq) const {
        const int row0 = u.pm * BM + wr * 64 + fr, c0 = u.pn * 256 + wc * 32 + 8 * fq;
        EPI_ROWLOOP { const int r = row0 + ai * HALF + m * 16; bf16_t* rowp = Y + (size_t)r * 1024 + c0; float s = 0.f;
#pragma unroll
            for (int bj = 0; bj < 2; ++bj) { const f32x4 v0 = acc[ai][bj][m][0], v1 = acc[ai][bj][m][1];
                s += (v0[0] * v0[0] + v0[1] * v0[1]) + (v0[2] * v0[2] + v0[3] * v0[3]) + (v1[0] * v1[0] + v1[1] * v1[1]) + (v1[2] * v1[2] + v1[3] * v1[3]);
                *(u32x4*)(rowp + bj * HALF) = pack8(v0, v1); }
            s += __shfl_xor(s, 16); s += __shfl_xor(s, 32);
            if (fq == 0) part[(size_t)r * 16 + u.pn * 4 + wc] = s; }
    }
};
struct EpiSwiglu {
    static constexpr bool PERM = true, AFTER_DRAIN = false;
    bf16_t* HID; int ldh;
    __device__ __forceinline__ void operator()(const f32x4 (&acc)[2][2][4][2], const Unit& u, int wr, int wc, int fr, int fq) const {
        const int row0 = u.pm * BM + wr * 64 + fr, c0 = u.pn * 128 + wc * 32 + 8 * fq;
        EPI_ROWLOOP { const int r = row0 + ai * HALF + m * 16;
            *(u32x4*)(HID + (size_t)r * ldh + c0) = pack8(silu4_new(acc[ai][0][m][0]) * acc[ai][1][m][0], silu4_new(acc[ai][0][m][1]) * acc[ai][1][m][1]); }
    }
};
struct PairOrder {
    StaticOrder so;
    __device__ bool next(int i, Unit& u) const { if (!so.next(i >> 1, u)) return false; u.sel = i & 1; return true; }
    __device__ __forceinline__ void a_ready(const Unit&) const {}
    __device__ __forceinline__ void done(const Unit&) const {}
};
template <class Epi, class Sched, bool ALIGN_EPI = false, bool SP2 = false>
__device__ __forceinline__ void gemm_phase(PG8_LAS unsigned char* lds, const Gemm g, const Sched& S, const Epi& E) {
    int tid_ = threadIdx.x; asm volatile("" : "+v"(tid_));
    const int tid = tid_, wid = __builtin_amdgcn_readfirstlane(tid >> 6), lane = tid & 63, wr = wid >> 2, wc = wid & 3, fr = lane & 15, fq = lane >> 4;
    int K_ = g.K; asm volatile("" : "+s"(K_));
    const int K = K_, nt = K / BK;
    unsigned voffA[2], voffB[2];
#pragma unroll
    for (int i = 0; i < 2; ++i) { int R, C; stage_rc(tid * 16 + i * 8192, R, C); const int Rb = Epi::PERM ? ((R & ~31) + perm32(R & 31)) : R;
        voffA[i] = (unsigned)(R * K + C) * 2u; voffB[i] = (unsigned)(Rb * K + C) * 2u; }
    const size_t kstep = (size_t)(BK * 2);
    const size_t hstep = (size_t)HALF * K * 2;
    const size_t tstep = 2 * hstep;
    const unsigned ldsw = (unsigned)wid * 1024u;
    const int aoff = lds_byte(wr * 64 + fr, fq * 8), boff = lds_byte(wc * 32 + fr, fq * 8);
#define PG8_SA(b, h) (((b) * 2 + (h)) * HTB)
#define PG8_SB(b, h) ((4 + (b) * 2 + (h)) * HTB)
#define PG8_STAGE(bufoff, gbase, voff) do { _Pragma("unroll") for (int _i = 0; _i < 2; ++_i) \
        __builtin_amdgcn_global_load_lds((const unsigned*)((const char*)(gbase) + (voff)[_i]), (PG8_LAS unsigned*)(lds + (bufoff) + ldsw + _i * 8192), 16, 0, 0); } while (0)
#define PG8_LDA(dst, b, h) do { _Pragma("unroll") for (int m = 0; m < 4; ++m) _Pragma("unroll") for (int k = 0; k < 2; ++k) dst[m][k] = *(const PG8_LAS bf16x8*)(lds + PG8_SA(b, h) + aoff + m * 2048 + k * 1024); } while (0)
#define PG8_LDB(dst, b, h) do { _Pragma("unroll") for (int n = 0; n < 2; ++n) _Pragma("unroll") for (int k = 0; k < 2; ++k) dst[n][k] = *(const PG8_LAS bf16x8*)(lds + PG8_SB(b, h) + boff + n * 2048 + k * 1024); } while (0)
#define PG8_MMA(ai, bj, At, Bt) do { __builtin_amdgcn_s_setprio(1); _Pragma("unroll") for (int m = 0; m < 4; ++m) _Pragma("unroll") for (int n = 0; n < 2; ++n) _Pragma("unroll") for (int k = 0; k < 2; ++k) \
        acc[ai][bj][m][n] = __builtin_amdgcn_mfma_f32_16x16x32_bf16(Bt[n][k], At[m][k], acc[ai][bj][m][n], 0, 0, 0); __builtin_amdgcn_s_setprio(0); } while (0)
#define PG8_WAIT_V(n) asm volatile("s_waitcnt vmcnt(" #n ")" ::: "memory")
#define PG8_WAIT_L(n) asm volatile("s_waitcnt lgkmcnt(" #n ")" ::: "memory")
#define PG8_BAR __builtin_amdgcn_s_barrier()
#define PG8_SCHED __builtin_amdgcn_sched_barrier(0)
    Unit cur, nxt; int ui = 0;
    if (!S.next(0, cur)) return;
    f32x4 acc[2][2][4][2];
#pragma unroll
    for (int a = 0; a < 2; ++a)
#pragma unroll
        for (int b = 0; b < 2; ++b)
#pragma unroll
            for (int m = 0; m < 4; ++m)
#pragma unroll
                for (int n = 0; n < 2; ++n) acc[a][b][m][n] = (f32x4){0.f, 0.f, 0.f, 0.f};
    bf16x8 At[4][2], B0[2][2], B1[2][2];
    const char* cA = (const char*)(cur.sel ? g.A2 : g.A) + (size_t)cur.pm * tstep; const char* cB = (const char*)(cur.sel ? g.Bt2 : g.Bt) + (size_t)cur.pn * tstep;
    S.a_ready(cur);
    if constexpr (SP2) {
        PG8_STAGE(PG8_SB(0, 0), cB, voffB); PG8_STAGE(PG8_SB(0, 1), cB + hstep, voffB); PG8_STAGE(PG8_SA(0, 0), cA, voffA); PG8_STAGE(PG8_SA(0, 1), cA + hstep, voffA);
        if (wr == 1) PG8_BAR;
        PG8_WAIT_V(2); PG8_BAR;
        PG8_STAGE(PG8_SB(1, 0), cB + kstep, voffB); PG8_STAGE(PG8_SA(1, 0), cA + kstep, voffA); PG8_STAGE(PG8_SB(1, 1), cB + hstep + kstep, voffB);
        PG8_WAIT_V(6); PG8_BAR;
    } else {
        PG8_STAGE(PG8_SB(0, 0), cB, voffB); PG8_STAGE(PG8_SA(0, 0), cA, voffA); PG8_STAGE(PG8_SB(0, 1), cB + hstep, voffB); PG8_STAGE(PG8_SA(0, 1), cA + hstep, voffA);
        if (wr == 1) PG8_BAR;
        PG8_WAIT_V(4); PG8_BAR;
        PG8_STAGE(PG8_SB(1, 0), cB + kstep, voffB); PG8_STAGE(PG8_SA(1, 0), cA + kstep, voffA); PG8_STAGE(PG8_SB(1, 1), cB + hstep + kstep, voffB);
        PG8_WAIT_V(6); PG8_BAR;
    }
    for (;;) {
        const bool has_next = S.next(ui + 1, nxt);
        const char* nA = has_next ? (const char*)(nxt.sel ? g.A2 : g.A) + (size_t)nxt.pm * tstep : cA; const char* nB = has_next ? (const char*)(nxt.sel ? g.Bt2 : g.Bt) + (size_t)nxt.pn * tstep : cB;
        for (int t = 0; t < nt; t += 2) {
            const bool last = (t == nt - 2);
            const char* a1 = cA + (size_t)(t + 1) * kstep;
            const char* a2 = last ? nA : cA + (size_t)(t + 2) * kstep; const char* b2 = last ? nB : cB + (size_t)(t + 2) * kstep;
            const char* a3 = a2 + kstep; const char* b3 = b2 + kstep;
            if (last && has_next) S.a_ready(nxt);
            if constexpr (SP2) {
            PG8_LDB(B0, 0, 0); PG8_LDB(B1, 0, 1); PG8_SCHED; PG8_LDA(At, 0, 0); PG8_STAGE(PG8_SA(1, 1), a1 + hstep, voffA);
            PG8_WAIT_V(8); PG8_WAIT_L(0); PG8_BAR; PG8_MMA(0, 0, At, B0); PG8_MMA(0, 1, At, B1); PG8_BAR; PG8_SCHED;
            PG8_LDA(At, 0, 1); PG8_STAGE(PG8_SB(0, 0), b2, voffB); PG8_STAGE(PG8_SB(0, 1), b2 + hstep, voffB); PG8_STAGE(PG8_SA(0, 0), a2, voffA);
            PG8_WAIT_V(8); PG8_WAIT_L(0); PG8_BAR; PG8_MMA(1, 0, At, B0); PG8_MMA(1, 1, At, B1); PG8_BAR; PG8_SCHED;
            PG8_LDB(B0, 1, 0); PG8_LDB(B1, 1, 1); PG8_SCHED; PG8_LDA(At, 1, 0); PG8_STAGE(PG8_SA(0, 1), a2 + hstep, voffA);
            PG8_WAIT_V(8); PG8_WAIT_L(0); PG8_BAR; PG8_MMA(0, 0, At, B0); PG8_MMA(0, 1, At, B1); PG8_BAR; PG8_SCHED;
            PG8_LDA(At, 1, 1); PG8_STAGE(PG8_SB(1, 0), b3, voffB); PG8_STAGE(PG8_SB(1, 1), b3 + hstep, voffB); PG8_STAGE(PG8_SA(1, 0), a3, voffA);
            PG8_WAIT_V(8); PG8_WAIT_L(0); PG8_BAR; PG8_MMA(1, 0, At, B0); PG8_MMA(1, 1, At, B1); PG8_BAR; PG8_SCHED;
            } else {
            PG8_LDB(B0, 0, 0); PG8_SCHED; PG8_LDA(At, 0, 0); PG8_STAGE(PG8_SA(1, 1), a1 + hstep, voffA);
            PG8_WAIT_L(8); PG8_BAR; PG8_WAIT_L(0); PG8_MMA(0, 0, At, B0); PG8_BAR; PG8_SCHED;
            PG8_LDB(B1, 0, 1); PG8_STAGE(PG8_SB(0, 0), b2, voffB);
            PG8_BAR; PG8_WAIT_L(0); PG8_MMA(0, 1, At, B1); PG8_BAR;
            PG8_LDA(At, 0, 1); PG8_STAGE(PG8_SA(0, 0), a2, voffA);
            PG8_BAR; PG8_WAIT_L(0); PG8_MMA(1, 0, At, B0); PG8_BAR; PG8_SCHED;
            PG8_STAGE(PG8_SB(0, 1), b2 + hstep, voffB);
            PG8_WAIT_V(6); PG8_BAR; PG8_MMA(1, 1, At, B1); PG8_BAR;
            PG8_LDB(B0, 1, 0); PG8_SCHED; PG8_LDA(At, 1, 0); PG8_STAGE(PG8_SA(0, 1), a2 + hstep, voffA);
            PG8_WAIT_L(8); PG8_BAR; PG8_WAIT_L(0); PG8_MMA(0, 0, At, B0); PG8_BAR; PG8_SCHED;
            PG8_LDB(B1, 1, 1); PG8_STAGE(PG8_SB(1, 0), b3, voffB);
            PG8_BAR; PG8_WAIT_L(0); PG8_MMA(0, 1, At, B1); PG8_BAR;
            PG8_LDA(At, 1, 1); PG8_STAGE(PG8_SA(1, 0), a3, voffA);
            PG8_BAR; PG8_WAIT_L(0); PG8_MMA(1, 0, At, B0); PG8_BAR; PG8_SCHED;
            PG8_STAGE(PG8_SB(1, 1), b3 + hstep, voffB);
            PG8_WAIT_V(6); PG8_BAR; PG8_MMA(1, 1, At, B1); PG8_BAR;
            }
        }
        if constexpr (ALIGN_EPI) { if (wr == 0) PG8_BAR; }
        if constexpr (!Epi::AFTER_DRAIN) { E(acc, cur, wr, wc, fr, fq); S.done(cur); }
        if (!has_next) break;
#pragma unroll
        for (int a = 0; a < 2; ++a)
#pragma unroll
            for (int b = 0; b < 2; ++b)
#pragma unroll
                for (int m = 0; m < 4; ++m)
#pragma unroll
                    for (int n = 0; n < 2; ++n) acc[a][b][m][n] = (f32x4){0.f, 0.f, 0.f, 0.f};
        cur = nxt; cA = nA; cB = nB; ++ui;
        if constexpr (ALIGN_EPI) { if (wr == 1) PG8_BAR; }
    }
    PG8_WAIT_V(0);
    if constexpr (!ALIGN_EPI) { if (wr == 0) PG8_BAR; }
    PG8_BAR;
    if constexpr (Epi::AFTER_DRAIN) { E.fused(acc, cur, wr, wc, fr, fq, lds, wid, lane); S.done(cur); }
#undef PG8_SA
#undef PG8_SB
#undef PG8_STAGE
#undef PG8_LDA
#undef PG8_LDB
#undef PG8_MMA
#undef PG8_WAIT_V
#undef PG8_WAIT_L
#undef PG8_BAR
#undef PG8_SCHED
}
}

struct Params {
    const float *x, *meta, *w_in, *b_gate, *lb_logits, *hg_norm_g, *w_hg_o, *q_a_norm_g, *w_q_b, *kv_a_norm_g, *w_kv_b, *w_mla_o, *w_out, *mix_pre_g, *mix_post_g, *ffn_pre_g, *ffn_post_g, *w_ffn_in, *w_ffn_out;
    float* out; unsigned char* ws;
};

#define LDS_WAIT() asm volatile("s_waitcnt lgkmcnt(0)" ::: "memory")
__device__ __forceinline__ unsigned cvtpk(float lo, float hi) { return pg8::cvt_pk_bf16(lo, hi); }
__device__ __forceinline__ float bf_lo(unsigned w) { return __uint_as_float(w << 16); }
__device__ __forceinline__ float bf_hi(unsigned w) { return __uint_as_float(w & 0xffff0000u); }
__device__ __forceinline__ float wave_sum(float v) {
#pragma unroll
    for (int o = 1; o < 64; o <<= 1) v += __shfl_xor(v, o);
    return v;
}
__device__ __forceinline__ float sigmf(float x) { return 1.0f / (1.0f + __expf(-x)); }

__device__ __forceinline__ void tr_item(const float* W, int K, int N, bf16* WT, int kb, int drow0, int n0, const float* gain, LAS float* scr, int lane) {
    const int k0 = 64 * kb;
#pragma unroll 8
    for (int i = 0; i < 32; ++i) { const int kk = 2 * i + (lane >> 5); float v = 0.f;
        if (n0 >= 0) { v = W[(size_t)(k0 + kk) * N + n0 + (lane & 31)]; if (gain) v *= gain[k0 + kk]; }
        scr[kk * 33 + (lane & 31)] = v; }
    LDS_WAIT(); asm volatile("" ::: "memory");
    const int c = lane & 7;
#pragma unroll
    for (int j = 0; j < 4; ++j) { const int n = (lane >> 3) + 8 * j; const LAS float* s = scr + (8 * c) * 33 + n;
        u32x4 o; o.x = cvtpk(s[0 * 33], s[1 * 33]); o.y = cvtpk(s[2 * 33], s[3 * 33]); o.z = cvtpk(s[4 * 33], s[5 * 33]); o.w = cvtpk(s[6 * 33], s[7 * 33]);
        *(u32x4*)(WT + (size_t)(drow0 + n) * K + k0 + 8 * c) = o; }
    LDS_WAIT(); asm volatile("" ::: "memory");
}
__device__ __forceinline__ int map_win(int db) { if (db < 144) return db * 32; if (db < 208) return db * 32 + 64; const int t = db - 208; return t == 0 ? 4608 : (t == 4 ? 4640 : -1); }
__device__ __forceinline__ int map_wqb(int db) { if (db < 32) return (db >> 2) * 192 + (db & 3) * 32; const int e = db - 32, t = e >> 3, bj = (e & 7) >> 2, hh = e & 3; return (4 * t + hh) * 192 + 128 + bj * 32; }
__device__ __forceinline__ int map_wkvb(int db) { if (db < 32) return (db >> 2) * 256 + (db & 3) * 32; const int e = db - 32; return (e >> 2) * 256 + 128 + (e & 3) * 32; }
__device__ __forceinline__ int map_wfin(int db) { const int t = db >> 3, bj = (db & 7) >> 2, jj = db & 3; return bj * FFH + t * 128 + jj * 32; }

__device__ __forceinline__ void p0_prologue(const Params& p, LAS unsigned char* lds) {
    int tid_ = threadIdx.x; asm volatile("" : "+v"(tid_));
    const int tid = tid_, lane = tid & 63, wave = tid >> 6, G = gridDim.x;
    const int gw = blockIdx.x * NWAVES + wave, NGW = G * NWAVES;
    const int gt = blockIdx.x * NTHREADS + tid, NGT = G * NTHREADS;
    unsigned char* ws = p.ws;
    { float* cs = (float*)(ws + WS_ROPE);
      for (int e = gt; e < (SEQ + NMETA) * 32; e += NGT) { const int pos = e >> 5, i = e & 31;
          double f = 1.0; { const double r1 = 0.74989420933245582730218427561514, r2 = r1 * r1, r4 = r2 * r2, r8 = r4 * r4, r16 = r8 * r8;
              if (i & 1) f *= r1; if (i & 2) f *= r2; if (i & 4) f *= r4; if (i & 8) f *= r8; if (i & 16) f *= r16; }
          double a = (double)pos * f; const double TWO_PI = 6.283185307179586476925286766559; a -= TWO_PI * __builtin_rint(a / TWO_PI);
          const double a2 = a * a; double sc = 1.0, ss = a, tc = 1.0, ts = a;
#pragma unroll 1
          for (int n = 1; n <= 14; ++n) { tc *= -a2 / (double)((2 * n - 1) * (2 * n)); ts *= -a2 / (double)((2 * n) * (2 * n + 1)); sc += tc; ss += ts; }
          cs[2 * e] = (float)sc; cs[2 * e + 1] = (float)ss; } }
    { LAS float* scr = (LAS float*)(lds + wave * 16384);
      constexpr int I0 = 16 * 216, I1 = 4 * 48, I2 = 4 * 64, I3 = 16 * 32, I6 = 16 * 176, I7 = 44 * 32;
      constexpr int NIT = I0 + I1 + I2 + 3 * I3 + I6 + I7;
      for (int it = gw; it < NIT; it += NGW) { int r = it;
          if (r < I0) { const int kb = r / 216, db = r % 216; tr_item(p.w_in, 1024, 6720, (bf16*)(ws + W_IN), kb, db * 32, map_win(db), nullptr, scr, lane); continue; } r -= I0;
          if (r < I1) { const int kb = r / 48, db = r % 48; tr_item(p.w_q_b, 256, 1536, (bf16*)(ws + W_QB), kb, db * 32, map_wqb(db), p.q_a_norm_g, scr, lane); continue; } r -= I1;
          if (r < I2) { const int kb = r / 64, db = r % 64; tr_item(p.w_kv_b, 256, 2048, (bf16*)(ws + W_KVB), kb, db * 32, map_wkvb(db), p.kv_a_norm_g, scr, lane); continue; } r -= I2;
          if (r < I3) { const int kb = r / 32, db = r % 32; tr_item(p.w_hg_o, 1024, 1024, (bf16*)(ws + W_HGO), kb, db * 32, db * 32, nullptr, scr, lane); continue; } r -= I3;
          if (r < I3) { const int kb = r / 32, db = r % 32; tr_item(p.w_mla_o, 1024, 1024, (bf16*)(ws + W_MLAO), kb, db * 32, db * 32, nullptr, scr, lane); continue; } r -= I3;
          if (r < I3) { const int kb = r / 32, db = r % 32; tr_item(p.w_out, 1024, 1024, (bf16*)(ws + W_OUT), kb, db * 32, db * 32, nullptr, scr, lane); continue; } r -= I3;
          if (r < I6) { const int kb = r / 176, db = r % 176; tr_item(p.w_ffn_in, 1024, 2 * FFH, (bf16*)(ws + W_FIN), kb, db * 32, map_wfin(db), nullptr, scr, lane); continue; } r -= I6;
          { const int kb = r / 32, db = r % 32; tr_item(p.w_ffn_out, FFH, 1024, (bf16*)(ws + W_FOUT), kb, db * 32, db * 32, nullptr, scr, lane); } } }
    { bf16* U = (bf16*)(ws + WS_R0);
      f32x4 gg[4];
#pragma unroll
      for (int j = 0; j < 4; ++j) gg[j] = *(const f32x4*)(p.mix_pre_g + 4 * lane + 256 * j);
      for (int r = gw; r < MP; r += 2 * NGW) {
          f32x4 v[2][4];
#pragma unroll
          for (int q = 0; q < 2; ++q) { const int rq = r + q * NGW;
#pragma unroll
              for (int j = 0; j < 4; ++j) v[q][j] = (f32x4){0.f, 0.f, 0.f, 0.f};
              if (rq < MR + NMETA) { const float* src = rq < MR ? p.x + (size_t)rq * DM : p.meta + (size_t)(rq - MR) * DM;
#pragma unroll
                  for (int j = 0; j < 4; ++j) v[q][j] = *(const f32x4*)(src + 4 * lane + 256 * j); } }
#pragma unroll
          for (int q = 0; q < 2; ++q) { const int rq = r + q * NGW; if (rq >= MP) break;
              u32x2* o8 = (u32x2*)(U + (size_t)rq * DM) + lane; float s = 0.f;
#pragma unroll
              for (int j = 0; j < 4; ++j) s += (v[q][j][0] * v[q][j][0] + v[q][j][1] * v[q][j][1]) + (v[q][j][2] * v[q][j][2] + v[q][j][3] * v[q][j][3]);
              const float rstd = __builtin_amdgcn_rsqf(wave_sum(s) * (1.0f / DM) + EPS);
#pragma unroll
              for (int j = 0; j < 4; ++j) { const f32x4 w = v[q][j] * rstd * gg[j]; o8[64 * j] = (u32x2){cvtpk(w[0], w[1]), cvtpk(w[2], w[3])}; } } } }
}

__device__ __forceinline__ void scan_phase(const Params& p, LAS unsigned char* lds) {
    const bf16* HQ = (const bf16*)(p.ws + WS_R1); const bf16* HF = (const bf16*)(p.ws + WS_R2); bf16* HIO = (bf16*)(p.ws + WS_R3); const bf16* HG = (const bf16*)(p.ws + WS_R4);
    LAS float* fS = (LAS float*)lds; LAS float* kS = fS + 2048; LAS float* qS = kS + 2048; LAS float* vS = qS + 2048; LAS float* gS = vS + 2048; LAS float* oP = gS + 2048;
    int tid_ = threadIdx.x; asm volatile("" : "+v"(tid_));
    const int tid = tid_, v = tid & 127, kq = tid >> 7, ls = tid >> 5, lk = (tid & 31) * 4;
    for (int item = blockIdx.x; item < NBATCH * 8; item += gridDim.x) {
        const int b = item >> 3, h = item & 7;
        float lbv[4], gn[4];
#pragma unroll
        for (int e = 0; e < 4; ++e) { const float l0 = p.lb_logits[h * 128 + lk + e], l1 = p.lb_logits[1024 + h * 128 + lk + e]; lbv[e] = 1.0f / (1.0f + __expf(l1 - l0)); gn[e] = p.hg_norm_g[lk + e]; }
        float S[32];
#pragma unroll
        for (int j = 0; j < 32; ++j) S[j] = 0.f;
        u32x2 rq, rf, ri, rg;
        { const size_t off = (size_t)(MR + ls) * DM + h * 128 + lk; rq = *(const u32x2*)(HQ + off); rf = *(const u32x2*)(HF + off); ri = *(const u32x2*)(HIO + off); rg = *(const u32x2*)(HG + off); }
        for (int ch = 0; ch <= 128; ++ch) {
            const int row0 = ch == 0 ? MR : b * SEQ + (ch - 1) * 16;
            { const float fx[4] = {bf_lo(rf.x), bf_hi(rf.x), bf_lo(rf.y), bf_hi(rf.y)};
              f32x4 f4, k4;
#pragma unroll
              for (int e = 0; e < 4; ++e) { const float f = lbv[e] + (1.0f - lbv[e]) * sigmf(fx[e]); f4[e] = f; k4[e] = 1.0f - f; }
              *(LAS f32x4*)(fS + ls * 128 + lk) = f4; *(LAS f32x4*)(kS + ls * 128 + lk) = k4;
              *(LAS f32x4*)(qS + ls * 128 + lk) = (f32x4){bf_lo(rq.x), bf_hi(rq.x), bf_lo(rq.y), bf_hi(rq.y)};
              *(LAS f32x4*)(vS + ls * 128 + lk) = (f32x4){bf_lo(ri.x), bf_hi(ri.x), bf_lo(ri.y), bf_hi(ri.y)};
              *(LAS f32x4*)(gS + ls * 128 + lk) = (f32x4){bf_lo(rg.x), bf_hi(rg.x), bf_lo(rg.y), bf_hi(rg.y)}; }
            __syncthreads();
            if (ch < 128) { const size_t off = (size_t)(b * SEQ + ch * 16 + ls) * DM + h * 128 + lk; rq = *(const u32x2*)(HQ + off); rf = *(const u32x2*)(HF + off); ri = *(const u32x2*)(HIO + off); rg = *(const u32x2*)(HG + off); }
#pragma unroll 2
            for (int s = 0; s < 16; ++s) { const float vv = vS[s * 128 + v]; float oa = 0.f;
#pragma unroll
                for (int j4 = 0; j4 < 8; ++j4) { const f32x4 f4 = *(const LAS f32x4*)(fS + s * 128 + 32 * kq + 4 * j4), k4 = *(const LAS f32x4*)(kS + s * 128 + 32 * kq + 4 * j4), q4 = *(const LAS f32x4*)(qS + s * 128 + 32 * kq + 4 * j4);
#pragma unroll
                    for (int e = 0; e < 4; ++e) { S[4 * j4 + e] = f4[e] * S[4 * j4 + e] + k4[e] * vv; oa += q4[e] * S[4 * j4 + e]; } }
                oP[(kq * 16 + s) * 128 + v] = oa; __builtin_amdgcn_sched_barrier(0); }
            __syncthreads();
            if (ch > 0) {
                f32x4 o4 = *(const LAS f32x4*)(oP + (0 * 16 + ls) * 128 + lk);
                o4 += *(const LAS f32x4*)(oP + (1 * 16 + ls) * 128 + lk); o4 += *(const LAS f32x4*)(oP + (2 * 16 + ls) * 128 + lk); o4 += *(const LAS f32x4*)(oP + (3 * 16 + ls) * 128 + lk);
                float ss = (o4[0] * o4[0] + o4[1] * o4[1]) + (o4[2] * o4[2] + o4[3] * o4[3]);
#pragma unroll
                for (int o = 1; o < 32; o <<= 1) ss += __shfl_xor(ss, o);
                const float rstd = __builtin_amdgcn_rsqf(ss * (1.0f / 128.0f) + EPS);
                const f32x4 g4 = *(const LAS f32x4*)(gS + ls * 128 + lk);
                const float o0 = o4[0] * rstd * gn[0] * g4[0], o1 = o4[1] * rstd * gn[1] * g4[1], o2 = o4[2] * rstd * gn[2] * g4[2], o3 = o4[3] * rstd * gn[3] * g4[3];
                *(u32x2*)(HIO + (size_t)(row0 + ls) * DM + h * 128 + lk) = (u32x2){cvtpk(o0, o1), cvtpk(o2, o3)};
            }
            __syncthreads();
        }
    }
}

struct ScanRaw { u32x4 a, b; };
struct ScanSt { s16x4 vf; float gv[4]; };
constexpr int SC_QD = 0, SC_KI = 4352, SC_KST = 8704, SC_DEC = 12800, SC_SSQ = 13312, SC_BUF = 16384, SC_RS = 272, SC_RAW = 2 * SC_BUF, SC_RAWSZ = 16384;
__device__ __forceinline__ float bf2f(unsigned h) { return __uint_as_float(h << 16); }
__device__ __forceinline__ void scan_load(ScanRaw& r, const bf16* P0, const bf16* P1, size_t off) { r.a = *(const u32x4*)(P0 + off); r.b = *(const u32x4*)(P1 + off); }
__device__ __forceinline__ void scan_stage(const ScanRaw& r, LAS unsigned char* raw, int tid) {
    const int row = (tid >> 4) & 15, slot = ((tid & 15) + 2 * (row >> 2)) & 15; LAS unsigned char* d = raw + (tid >> 8) * 4096 + row * 256 + slot * 16;
    *(LAS u32x4*)(d) = r.a; *(LAS u32x4*)(d + 8192) = r.b;
}
__device__ __forceinline__ void scan_gate(const LAS unsigned char* raw, ScanSt& st, LAS unsigned char* buf, float lb, int w, int l16, int g) {
    const float L2E = 1.4426950408889634f;
    const LAS unsigned char* e = raw + (4 * g) * 256 + ((2 * w + (l16 >> 3) + 2 * g) & 15) * 16 + (l16 & 7) * 2;
    unsigned rq[4], rf[4], rv[4], rg[4];
#pragma unroll
    for (int j = 0; j < 4; ++j) { rq[j] = *(const LAS unsigned short*)(e + j * 256); rf[j] = *(const LAS unsigned short*)(e + 4096 + j * 256); rv[j] = *(const LAS unsigned short*)(e + 8192 + j * 256); rg[j] = *(const LAS unsigned short*)(e + 12288 + j * 256); }
    float qv[4], kk[4], cs[4]; float run = 0.f;
#pragma unroll
    for (int j = 0; j < 4; ++j) { const float x = bf2f(rf[j]); const float sg = __builtin_amdgcn_rcpf(1.0f + __builtin_amdgcn_exp2f(-x * L2E));
        const float f = lb + (1.0f - lb) * sg; kk[j] = (1.0f - lb) * (1.0f - sg); run += __builtin_amdgcn_logf(f); cs[j] = run; qv[j] = bf2f(rq[j]); }
    const float T = run, t1 = __shfl_xor(T, 16), t2 = __shfl_xor(T, 32), t3 = __shfl_xor(t1, 32);
    const float E = g == 0 ? 0.f : (g == 1 ? t1 : (g == 2 ? (t2 + t3) : (t1 + t2 + t3))), blast = (T + t1) + (t2 + t3);
    float qd[4], ki[4], ks[4]; const float dec = __builtin_amdgcn_exp2f(blast);
#pragma unroll
    for (int j = 0; j < 4; ++j) { const float bj = E + cs[j]; qd[j] = qv[j] * __builtin_amdgcn_exp2f(bj); ki[j] = kk[j] * __builtin_amdgcn_exp2f(-bj); ks[j] = ki[j] * dec; }
    const int colb = (16 * w + l16) * 2;
    const unsigned q01 = cvtpk(qd[0], qd[1]), q23 = cvtpk(qd[2], qd[3]), k01 = cvtpk(ki[0], ki[1]), k23 = cvtpk(ki[2], ki[3]);
    LAS unsigned char* qp = buf + SC_QD + (4 * g) * SC_RS + colb; LAS unsigned char* kp = buf + SC_KI + (4 * g) * SC_RS + colb;
    *(LAS unsigned short*)(qp) = (unsigned short)(q01 & 0xffffu); *(LAS unsigned short*)(qp + SC_RS) = (unsigned short)(q01 >> 16);
    *(LAS unsigned short*)(qp + 2 * SC_RS) = (unsigned short)(q23 & 0xffffu); *(LAS unsigned short*)(qp + 3 * SC_RS) = (unsigned short)(q23 >> 16);
    *(LAS unsigned short*)(kp) = (unsigned short)(k01 & 0xffffu); *(LAS unsigned short*)(kp + SC_RS) = (unsigned short)(k01 >> 16);
    *(LAS unsigned short*)(kp + 2 * SC_RS) = (unsigned short)(k23 & 0xffffu); *(LAS unsigned short*)(kp + 3 * SC_RS) = (unsigned short)(k23 >> 16);
    *(LAS u32x2*)(buf + SC_KST + (16 * w + l16) * 32 + 8 * g) = (u32x2){cvtpk(ks[0], ks[1]), cvtpk(ks[2], ks[3])};
    if (g == 0) *(LAS float*)(buf + SC_DEC + (16 * w + l16) * 4) = dec;
    st.vf = __builtin_bit_cast(s16x4, (u32x2){rv[0] | (rv[1] << 16), rv[2] | (rv[3] << 16)});
#pragma unroll
    for (int j = 0; j < 4; ++j) st.gv[j] = bf2f(rg[j]);
}
__device__ __forceinline__ bf16x8 cat44(const s16x4 a, const s16x4 b) { return (bf16x8){a[0], a[1], a[2], a[3], b[0], b[1], b[2], b[3]}; }
__device__ __forceinline__ void scan_mma(f32x4 (&St)[8], const ScanSt& st, f32x4& o, LAS unsigned char* buf, int w, int l16, int g) {
    const LAS unsigned char* qp = buf + SC_QD + l16 * SC_RS + 8 * g; const LAS unsigned char* kp = buf + SC_KI + l16 * SC_RS + 8 * g;
    bf16x8 qd[4], ki[4];
#pragma unroll
    for (int ks = 0; ks < 4; ++ks) { qd[ks] = cat44(*(const LAS s16x4*)(qp + 64 * ks), *(const LAS s16x4*)(qp + 64 * ks + 32)); ki[ks] = cat44(*(const LAS s16x4*)(kp + 64 * ks), *(const LAS s16x4*)(kp + 64 * ks + 32)); }
    f32x4 at = {0.f, 0.f, 0.f, 0.f};
#pragma unroll
    for (int ks = 0; ks < 4; ++ks) at = __builtin_amdgcn_mfma_f32_16x16x32_bf16(ki[ks], qd[ks], at, 0, 0, 0);
#pragma unroll
    for (int i = 0; i < 4; ++i) if (4 * g + i > l16) at[i] = 0.f;
    const s16x4 pf = __builtin_bit_cast(s16x4, (u32x2){cvtpk(at[0], at[1]), cvtpk(at[2], at[3])});
    f32x4 oo = {0.f, 0.f, 0.f, 0.f};
#pragma unroll
    for (int ks = 0; ks < 4; ++ks) { const f32x4 s0 = St[2 * ks], s1 = St[2 * ks + 1];
        const bf16x8 sb = __builtin_bit_cast(bf16x8, (u32x4){cvtpk(s0[0], s0[1]), cvtpk(s0[2], s0[3]), cvtpk(s1[0], s1[1]), cvtpk(s1[2], s1[3])});
        oo = __builtin_amdgcn_mfma_f32_16x16x32_bf16(qd[ks], sb, oo, 0, 0, 0); }
    oo = __builtin_amdgcn_mfma_f32_16x16x16bf16_1k(pf, st.vf, oo, 0, 0, 0);
#pragma unroll
    for (int kt = 0; kt < 8; ++kt) { const s16x4 kst = *(const LAS s16x4*)(buf + SC_KST + (16 * kt + l16) * 32 + 8 * g); const f32x4 d4 = *(const LAS f32x4*)(buf + SC_DEC + (16 * kt + 4 * g) * 4);
        St[kt] = __builtin_amdgcn_mfma_f32_16x16x16bf16_1k(kst, st.vf, St[kt] * d4, 0, 0, 0); }
    o = oo;
    f32x4 q2 = oo * oo;
#pragma unroll
    for (int off = 1; off < 16; off <<= 1) { q2[0] += __shfl_xor(q2[0], off); q2[1] += __shfl_xor(q2[1], off); q2[2] += __shfl_xor(q2[2], off); q2[3] += __shfl_xor(q2[3], off); }
    if (l16 == 0) *(LAS f32x4*)(buf + SC_SSQ + (w * 16 + 4 * g) * 4) = q2;
}
__device__ __forceinline__ void scan_finish(const f32x4& o, const ScanSt& st, const LAS unsigned char* buf, bf16* HIO, size_t off, float gn, int g) {
    f32x4 tot = {0.f, 0.f, 0.f, 0.f};
#pragma unroll
    for (int w8 = 0; w8 < 8; ++w8) tot += *(const LAS f32x4*)(buf + SC_SSQ + (w8 * 16 + 4 * g) * 4);
#pragma unroll
    for (int i = 0; i < 4; ++i) { const float val = o[i] * __builtin_amdgcn_rsqf(tot[i] * (1.0f / 128.0f) + EPS) * gn * st.gv[i]; HIO[off + (size_t)i * DM] = (unsigned short)(cvtpk(val, 0.f) & 0xffffu); }
}
__device__ __forceinline__ void scan_mfma_phase(const Params& p, LAS unsigned char* lds) {
    const bf16* HQ = (const bf16*)(p.ws + WS_R1); const bf16* HF = (const bf16*)(p.ws + WS_R2); bf16* HIO = (bf16*)(p.ws + WS_R3); const bf16* HG = (const bf16*)(p.ws + WS_R4);
    int tid_ = threadIdx.x; asm volatile("" : "+v"(tid_));
    const int lane = tid_ & 63, w = __builtin_amdgcn_readfirstlane(tid_ >> 6), l16 = lane & 15, g = lane >> 4;
    LAS unsigned char* buf0 = lds; LAS unsigned char* buf1 = lds + SC_BUF;
    for (int item = blockIdx.x; item < NBATCH * 8; item += gridDim.x) {
        const int b = item >> 3, h = item & 7, col = h * 128 + 16 * w + l16;
        const float lb = 1.0f / (1.0f + __expf(p.lb_logits[1024 + col] - p.lb_logits[col])), gn = p.hg_norm_g[16 * w + l16];
        f32x4 St[8];
#pragma unroll
        for (int kt = 0; kt < 8; ++kt) St[kt] = (f32x4){0.f, 0.f, 0.f, 0.f};
#define SC_OFF(c) (((c) == 0 ? (size_t)MR : (size_t)b * SEQ + (size_t)((c) - 1) * 16) + 4 * g) * DM + col
#define SC_BAR() asm volatile("s_waitcnt lgkmcnt(0)\n\ts_barrier" ::: "memory")
        const bf16* P0 = (tid_ >> 8) ? HF : HQ; const bf16* P1 = (tid_ >> 8) ? HG : (const bf16*)HIO;
#define SC_LOFF(c) ((((c) == 0 ? (size_t)MR : (size_t)b * SEQ + (size_t)((c) - 1) * 16) + ((tid_ >> 4) & 15)) * DM + h * 128 + (tid_ & 15) * 8)
#define SC_LOFFC(c) SC_LOFF(((c) < 128 ? (c) : 128))
#define SC_SLOT(c) (lds + SC_RAW + ((c) % 3) * SC_RAWSZ)
        ScanRaw rawA, rawB; ScanSt st0, st1; f32x4 oprev = {0.f, 0.f, 0.f, 0.f};
        scan_load(rawA, P0, P1, SC_LOFF(0)); scan_load(rawB, P0, P1, SC_LOFF(1));
        scan_stage(rawA, SC_SLOT(0), tid_); scan_stage(rawB, SC_SLOT(1), tid_);
        scan_load(rawB, P0, P1, SC_LOFF(2));
        SC_BAR();
        scan_gate(SC_SLOT(0), st0, buf0, lb, w, l16, g);
        SC_BAR();
        for (int i = 0; i < 130; i += 2) {
            scan_load(rawA, P0, P1, SC_LOFFC(i + 3));
            if (i >= 2) scan_finish(oprev, st1, buf1, HIO, SC_OFF(i - 1), gn, g);
            if (w < 4) { scan_gate(SC_SLOT(i + 1), st1, buf1, lb, w, l16, g); scan_mma(St, st0, oprev, buf0, w, l16, g); }
            else       { scan_mma(St, st0, oprev, buf0, w, l16, g); scan_gate(SC_SLOT(i + 1), st1, buf1, lb, w, l16, g); }
            scan_stage(rawB, SC_SLOT(i + 2), tid_);
            SC_BAR();
            scan_load(rawB, P0, P1, SC_LOFFC(i + 4));
            if (i >= 2) scan_finish(oprev, st0, buf0, HIO, SC_OFF(i), gn, g);
            if (w < 4) { scan_gate(SC_SLOT(i + 2), st0, buf0, lb, w, l16, g); scan_mma(St, st1, oprev, buf1, w, l16, g); }
            else       { scan_mma(St, st1, oprev, buf1, w, l16, g); scan_gate(SC_SLOT(i + 2), st0, buf0, lb, w, l16, g); }
            scan_stage(rawA, SC_SLOT(i + 3), tid_);
            SC_BAR();
        }
#undef SC_LOFF
#undef SC_LOFFC
#undef SC_SLOT
#undef SC_OFF
#undef SC_BAR
        __syncthreads();
    }
}

__device__ __forceinline__ int crow(int r, int hi) { return (r & 3) + 8 * (r >> 2) + 4 * hi; }
typedef short v4i16_t __attribute__((ext_vector_type(4)));
__device__ __forceinline__ s16x4 vtr(const LAS unsigned char* ptr) { return __builtin_bit_cast(s16x4, __builtin_amdgcn_ds_read_tr16_b64_v4i16((LAS v4i16_t*)ptr)); }
constexpr int KS_STRIDE = 400, VS_STRIDE = 320  , KBUF = 64 * KS_STRIDE, VBUF = 64 * VS_STRIDE, ABUF = KBUF + VBUF;
__device__ __forceinline__ void attn_phase(const Params& p, LAS unsigned char* lds) {
    const bf16* QN = (const bf16*)(p.ws + WS_R1); const bf16* QR = (const bf16*)(p.ws + WS_R2); const bf16* KN = (const bf16*)(p.ws + WS_R0); const bf16* VV = (const bf16*)(p.ws + WS_R5);
    const bf16* KPE = (const bf16*)(p.ws + WS_KPE); bf16* AO = (bf16*)(p.ws + WS_R4);
    int tid_ = threadIdx.x; asm volatile("" : "+v"(tid_));
    const int tid = tid_, lane = tid & 63, wid = tid >> 6, c = lane & 31, hi = lane >> 5;
    const float NEG = -__builtin_inff();
    const int srow = tid >> 3, ssub = tid & 7;
    const int G_ = gridDim.x, vcu = (G_ % 8 == 0) ? (int)(blockIdx.x & 7) * (G_ >> 3) + (int)(blockIdx.x >> 3) : (int)blockIdx.x;
    for (int it = vcu; it < NBATCH * 8 * 4; it += G_) {
        const int bh = it >> 2, pp = it & 3, b = bh >> 3, h = bh & 7;
        for (int half = 0; half < 2; ++half) {
            const int qblk = half ? 7 - pp : pp;
            const int tq = qblk * 256 + wid * 32 + c;
            const size_t rowq = (size_t)b * SEQ + tq;
            bf16x8 qf[12];
#pragma unroll
            for (int d = 0; d < 8; ++d) qf[d] = *(const bf16x8*)(QN + rowq * 1024 + h * 128 + d * 16 + hi * 8);
#pragma unroll
            for (int d = 0; d < 4; ++d) qf[8 + d] = *(const bf16x8*)(QR + rowq * 512 + h * 64 + d * 16 + hi * 8);
            float mrun = -1e30f, lrun = 0.f; f32x16 o[4];
#pragma unroll
            for (int d = 0; d < 4; ++d) o[d] = (f32x16){};
            const int ntiles = 4 * qblk + 5;
            u32x4 kreg[3], vreg[2];
#define LOAD_TILE(JT) do { const int jt_ = (JT); const size_t base_ = jt_ == 0 ? (size_t)MR : (size_t)b * SEQ + (size_t)(jt_ - 1) * 64; const int nvalid_ = jt_ == 0 ? NMETA : 64; \
                kreg[0] = kreg[1] = kreg[2] = vreg[0] = vreg[1] = (u32x4){0u, 0u, 0u, 0u}; \
                if (srow < nvalid_) { const size_t r_ = base_ + srow; const size_t o_ = r_ * 1024 + h * 128 + ssub * 8; \
                    kreg[0] = *(const u32x4*)(KN + o_); kreg[1] = *(const u32x4*)(KN + o_ + 64); kreg[2] = *(const u32x4*)(KPE + r_ * 64 + ssub * 8); \
                    vreg[0] = *(const u32x4*)(VV + o_); vreg[1] = *(const u32x4*)(VV + o_ + 64); } } while (0)
            LOAD_TILE(0);
            for (int jt = 0; jt < ntiles; ++jt) {
                LAS unsigned char* Ks = lds + (jt & 1) * ABUF; LAS unsigned char* Vs = Ks + KBUF;
                { LAS unsigned char* kd = Ks + srow * KS_STRIDE + ssub * 16; LAS unsigned char* vd = Vs + srow * VS_STRIDE + ssub * 16;
                  *(LAS u32x4*)(kd) = kreg[0]; *(LAS u32x4*)(kd + 128) = kreg[1]; *(LAS u32x4*)(kd + 256) = kreg[2]; *(LAS u32x4*)(vd) = vreg[0]; *(LAS u32x4*)(vd + 128) = vreg[1]; }
                __syncthreads();
                if (jt + 1 < ntiles) LOAD_TILE(jt + 1);
                __builtin_amdgcn_sched_barrier(0);
                f32x16 p0 = (f32x16){}, p1 = (f32x16){};
                { const LAS unsigned char* kp = Ks + c * KS_STRIDE + hi * 16;
                  bf16x8 a0 = *(const LAS bf16x8*)(kp), a1 = *(const LAS bf16x8*)(kp + 32 * KS_STRIDE);
#pragma unroll
                  for (int d = 0; d < 12; ++d) { bf16x8 n0 = a0, n1 = a1;
                      if (d < 11) { n0 = *(const LAS bf16x8*)(kp + (d + 1) * 32); n1 = *(const LAS bf16x8*)(kp + 32 * KS_STRIDE + (d + 1) * 32); }
                      p0 = __builtin_amdgcn_mfma_f32_32x32x16_bf16(a0, qf[d], p0, 0, 0, 0); p1 = __builtin_amdgcn_mfma_f32_32x32x16_bf16(a1, qf[d], p1, 0, 0, 0);
                      a0 = n0; a1 = n1; } }
                const LAS unsigned char* vb = Vs + (4 * hi + ((lane & 15) >> 2)) * VS_STRIDE + (((lane >> 4) & 1) * 16 + 4 * (lane & 3)) * 2;
                s16x4 vlo[2][4], vhi[2][4];
#pragma unroll
                for (int s = 0; s < 4; ++s) { vlo[0][s] = vtr(vb + (16 * s) * VS_STRIDE); vhi[0][s] = vtr(vb + (16 * s + 8) * VS_STRIDE); }
                if (jt == 0) {
#pragma unroll
                    for (int r = 0; r < 16; ++r) { if (crow(r, hi) >= NMETA) p0[r] = NEG; p1[r] = NEG; }
                } else if (jt - 1 >= 4 * qblk) {
                    const int kb = 64 * (jt - 1);
#pragma unroll
                    for (int r = 0; r < 16; ++r) { const int key = kb + crow(r, hi); if (key > tq) p0[r] = NEG; if (key + 32 > tq) p1[r] = NEG; }
                }
                float rm = p0[0];
#pragma unroll
                for (int r = 1; r < 16; ++r) rm = fmaxf(rm, p0[r]);
#pragma unroll
                for (int r = 0; r < 16; ++r) rm = fmaxf(rm, p1[r]);
                rm = fmaxf(rm, __shfl_xor(rm, 32));
                const float mn = fmaxf(mrun, rm), alpha = __builtin_amdgcn_exp2f(mrun - mn); mrun = mn;
                float ps = 0.f;
#pragma unroll
                for (int r = 0; r < 16; ++r) { p0[r] = __builtin_amdgcn_exp2f(p0[r] - mn); p1[r] = __builtin_amdgcn_exp2f(p1[r] - mn); ps += p0[r] + p1[r]; }
                lrun = lrun * alpha + ps;
                if (__any(alpha != 1.0f)) {
#pragma unroll
                    for (int d = 0; d < 4; ++d) o[d] *= alpha; }
                bf16x8 pf[4];
#pragma unroll
                for (int s = 0; s < 2; ++s) {
                    u32x4 w0 = {cvtpk(p0[8 * s + 0], p0[8 * s + 1]), cvtpk(p0[8 * s + 2], p0[8 * s + 3]), cvtpk(p0[8 * s + 4], p0[8 * s + 5]), cvtpk(p0[8 * s + 6], p0[8 * s + 7])};
                    u32x4 w1 = {cvtpk(p1[8 * s + 0], p1[8 * s + 1]), cvtpk(p1[8 * s + 2], p1[8 * s + 3]), cvtpk(p1[8 * s + 4], p1[8 * s + 5]), cvtpk(p1[8 * s + 6], p1[8 * s + 7])};
                    pf[s] = __builtin_bit_cast(bf16x8, w0); pf[2 + s] = __builtin_bit_cast(bf16x8, w1); }
#pragma unroll
                for (int d = 0; d < 4; ++d) {
                    if (d < 3) {
#pragma unroll
                        for (int s = 0; s < 4; ++s) { vlo[(d + 1) & 1][s] = vtr(vb + (16 * s) * VS_STRIDE + (d + 1) * 64); vhi[(d + 1) & 1][s] = vtr(vb + (16 * s + 8) * VS_STRIDE + (d + 1) * 64); } }
#pragma unroll
                    for (int s = 0; s < 4; ++s) {
                        const s16x4 lo = vlo[d & 1][s], hh = vhi[d & 1][s];
                        const bf16x8 vf = {lo[0], lo[1], lo[2], lo[3], hh[0], hh[1], hh[2], hh[3]};
                        o[d] = __builtin_amdgcn_mfma_f32_32x32x16_bf16(vf, pf[s], o[d], 0, 0, 0); } }
            }
            __syncthreads();
            const float ltot = lrun + __shfl_xor(lrun, 32), inv = 1.0f / ltot;
            bf16* orow = AO + rowq * 1024 + h * 128;
#pragma unroll
            for (int d = 0; d < 4; ++d)
#pragma unroll
                for (int g = 0; g < 4; ++g)
                    *(u32x2*)(orow + d * 32 + 8 * g + 4 * hi) = (u32x2){cvtpk(o[d][4 * g] * inv, o[d][4 * g + 1] * inv), cvtpk(o[d][4 * g + 2] * inv, o[d][4 * g + 3] * inv)};
        }
    }
}

__device__ __forceinline__ void rows1_phase(const Params& p) {
    const bf16* Y = (const bf16*)(p.ws + WS_R0); const f32x4* part = (const f32x4*)(p.ws + PART_1); bf16* U2 = (bf16*)(p.ws + WS_R1);
    int tid_ = threadIdx.x; asm volatile("" : "+v"(tid_));
    const int lane = tid_ & 63, gw = blockIdx.x * NWAVES + (tid_ >> 6), NGW = gridDim.x * NWAVES;
    f32x4 gp[4], g2[4];
#pragma unroll
    for (int j = 0; j < 4; ++j) { gp[j] = *(const f32x4*)(p.mix_post_g + 4 * lane + 256 * j); g2[j] = *(const f32x4*)(p.ffn_pre_g + 4 * lane + 256 * j); }
    for (int r = gw; r < MR; r += 2 * NGW) {
        u32x2 y[2][4]; f32x4 xv[2][4], qp[2][4];
#pragma unroll
        for (int q = 0; q < 2; ++q) { const size_t rr = (size_t)(r + q * NGW < MR ? r + q * NGW : r);
#pragma unroll
            for (int j = 0; j < 4; ++j) { y[q][j] = *((const u32x2*)(Y + rr * DM) + lane + 64 * j); xv[q][j] = *(const f32x4*)(p.x + rr * DM + 4 * lane + 256 * j); qp[q][j] = part[rr * 4 + j]; } }
#pragma unroll
        for (int q = 0; q < 2; ++q) { const int rq = r + q * NGW; if (rq >= MR) break; const size_t rr = (size_t)rq;
            const f32x4 qs = (qp[q][0] + qp[q][1]) + (qp[q][2] + qp[q][3]);
            const float rs = __builtin_amdgcn_rsqf(((qs[0] + qs[1]) + (qs[2] + qs[3])) * (1.0f / DM) + EPS);
            f32x4 hv[4]; float s = 0.f;
#pragma unroll
            for (int j = 0; j < 4; ++j) { const f32x4 yv = {bf_lo(y[q][j].x), bf_hi(y[q][j].x), bf_lo(y[q][j].y), bf_hi(y[q][j].y)};
                hv[j] = xv[q][j] + yv * rs * gp[j]; *((u32x2*)(p.out + rr * DM) + lane + 64 * j) = (u32x2){cvtpk(hv[j][0], hv[j][1]), cvtpk(hv[j][2], hv[j][3])};
                s += (hv[j][0] * hv[j][0] + hv[j][1] * hv[j][1]) + (hv[j][2] * hv[j][2] + hv[j][3] * hv[j][3]); }
            const float rs2 = __builtin_amdgcn_rsqf(wave_sum(s) * (1.0f / DM) + EPS);
#pragma unroll
            for (int j = 0; j < 4; ++j) { const f32x4 w = hv[j] * rs2 * g2[j]; *((u32x2*)(U2 + rr * DM) + lane + 64 * j) = (u32x2){cvtpk(w[0], w[1]), cvtpk(w[2], w[3])}; } }
    }
}
__device__ __forceinline__ void rows2_phase(const Params& p) {
    const bf16* Y = (const bf16*)(p.ws + WS_R0); const f32x4* part = (const f32x4*)(p.ws + PART_2);
    int tid_ = threadIdx.x; asm volatile("" : "+v"(tid_));
    const int lane = tid_ & 63, gw = blockIdx.x * NWAVES + (tid_ >> 6), NGW = gridDim.x * NWAVES;
    f32x4 gp[4];
#pragma unroll
    for (int j = 0; j < 4; ++j) gp[j] = *(const f32x4*)(p.ffn_post_g + 4 * lane + 256 * j);
    for (int r = gw; r < MR; r += 2 * NGW) {
        u32x2 y[2][4], hb[2][4]; f32x4 qp[2][4];
#pragma unroll
        for (int q = 0; q < 2; ++q) { const size_t rr = (size_t)(r + q * NGW < MR ? r + q * NGW : r);
#pragma unroll
            for (int j = 0; j < 4; ++j) { y[q][j] = *((const u32x2*)(Y + rr * DM) + lane + 64 * j); hb[q][j] = *((const u32x2*)(p.out + rr * DM) + lane + 64 * j); qp[q][j] = part[rr * 4 + j]; } }
        asm volatile("s_waitcnt vmcnt(0)" ::: "memory");
#pragma unroll
        for (int q = 0; q < 2; ++q) { const int rq = r + q * NGW; if (rq >= MR) break; const size_t rr = (size_t)rq;
            const f32x4 qs = (qp[q][0] + qp[q][1]) + (qp[q][2] + qp[q][3]);
            const float rs = __builtin_amdgcn_rsqf(((qs[0] + qs[1]) + (qs[2] + qs[3])) * (1.0f / DM) + EPS);
#pragma unroll
            for (int j = 0; j < 4; ++j) { const f32x4 yv = {bf_lo(y[q][j].x), bf_hi(y[q][j].x), bf_lo(y[q][j].y), bf_hi(y[q][j].y)};
                const f32x4 h1 = {bf_lo(hb[q][j].x), bf_hi(hb[q][j].x), bf_lo(hb[q][j].y), bf_hi(hb[q][j].y)};
                *(f32x4*)(p.out + rr * DM + 4 * lane + 256 * j) = h1 + yv * rs * gp[j]; } }
    }
}

#define XB_TMO      128
#define XB_XCNT(j)  (256  + 64 * (j))
#define XB_XSUB(j)  (1280 + 64 * (j))
#define XB_XGEN(j)  (2304 + 64 * (j))
#define XB_TOP      3328
#define XB_TOPGEN   3392
#define XCD_BAR_WORDS 3456
#define XB_SPIN_CAP (1u << 18)

__device__ __forceinline__ unsigned xb_ld(unsigned* p)              { return __hip_atomic_load(p, __ATOMIC_RELAXED, __HIP_MEMORY_SCOPE_AGENT); }
__device__ __forceinline__ unsigned xb_add(unsigned* p, unsigned v) { return __hip_atomic_fetch_add(p, v, __ATOMIC_RELAXED, __HIP_MEMORY_SCOPE_AGENT); }
__device__ __forceinline__ unsigned xb_xcc_id() { return (unsigned)__builtin_amdgcn_s_getreg((3 << 11) | 20) & 0xFu; }
#define XB_SPIN(cond, bar) do { unsigned _sp = 0; while (cond) { __builtin_amdgcn_s_sleep(1); \
    if ((++_sp & 255u) == 0u) { if (xb_ld(&(bar)[XB_TMO])) break; if (_sp > XB_SPIN_CAP) { atomicAdd(&(bar)[XB_TMO], 1u); break; } } } } while (0)

struct XcdBarrier {
    unsigned* bar; unsigned x;
    volatile LAS unsigned* st;
};

__device__ __forceinline__ XcdBarrier xcd_barrier_post(unsigned* bar, volatile LAS unsigned* st) {
    XcdBarrier b; b.bar = bar; b.x = xb_xcc_id(); b.st = st;
    if (threadIdx.x == 0) (void)xb_add(&bar[XB_XCNT(b.x)], 1u);
    return b;
}
__device__ __forceinline__ void xcd_barrier_complete(unsigned* bar, unsigned x, unsigned& nloc, unsigned& nx) {
    const unsigned G = gridDim.x * gridDim.y * gridDim.z;
    unsigned sum, cnt, mine, sp = 0u;
    for (;;) {
        sum = 0u; cnt = 0u; mine = 0u;
#pragma unroll
        for (unsigned j = 0; j < 16; ++j) { const unsigned c = xb_ld(&bar[XB_XCNT(j)]); sum += c; cnt += (c > 0u) ? 1u : 0u; mine = (j == x) ? c : mine; }
        if (sum == G) break;
        __builtin_amdgcn_s_sleep(1);
        if ((++sp & 255u) == 0u) { if (xb_ld(&bar[XB_TMO])) break; if (sp > XB_SPIN_CAP) { atomicAdd(&bar[XB_TMO], 1u); break; } }
    }
    nloc = mine > 0u ? mine : 1u; nx = cnt > 0u ? cnt : 1u;
}

__device__ __forceinline__ void xcd_barrier(const XcdBarrier& b) {
    asm volatile("s_waitcnt vmcnt(0)" ::: "memory");
    __syncthreads();
    if (threadIdx.x == 0) {
        unsigned* bar = b.bar;
        __builtin_amdgcn_s_waitcnt(0);
        unsigned nloc = b.st[0], nx = b.st[1];
        if (nloc == 0u) { xcd_barrier_complete(bar, b.x, nloc, nx); b.st[0] = nloc; b.st[1] = nx; }
        const unsigned old = xb_add(&bar[XB_XSUB(b.x)], 1u);
        const unsigned gen = old / nloc;
        if (old + 1u == (gen + 1u) * nloc) {
            __builtin_amdgcn_fence(__ATOMIC_RELEASE, "agent");
            asm volatile("s_waitcnt vmcnt(0)" ::: "memory");
            const unsigned og = xb_add(&bar[XB_TOP], 1u);
            const unsigned tg = og / nx;
            if (og + 1u == (tg + 1u) * nx) xb_add(&bar[XB_TOPGEN], 1u);
            else XB_SPIN(xb_ld(&bar[XB_TOPGEN]) == tg, bar);
            __builtin_amdgcn_fence(__ATOMIC_ACQUIRE, "agent");
            xb_add(&bar[XB_XGEN(b.x)], 1u);
            asm volatile("s_waitcnt vmcnt(0)" ::: "memory");
        } else {
            XB_SPIN(xb_ld(&bar[XB_XGEN(b.x)]) == gen, bar);
            __builtin_amdgcn_fence(__ATOMIC_ACQUIRE, "agent");
            asm volatile("s_waitcnt vmcnt(0)" ::: "memory");
        }
    }
    __syncthreads();
}

#ifndef PH_LAST
#define PH_LAST 99
#endif
__global__ void __launch_bounds__(NTHREADS, 2) fwd_megakernel(Params p) {
    extern __shared__ __attribute__((aligned(16))) unsigned char lds_raw[];
    LAS unsigned char* lds = (LAS unsigned char*)lds_raw;
    cg::grid_group grid = cg::this_grid();
    for (int u = threadIdx.x; u < 64; u += NTHREADS) ((LAS unsigned*)(lds + XB_LDS_OFF))[u] = 0u;
    __syncthreads();
    const XcdBarrier xbar = xcd_barrier_post((unsigned*)(p.ws + WS_BAR), (volatile LAS unsigned*)(lds + XB_LDS_OFF));
    if (p.ws == nullptr) grid.sync();
#define GRID_SYNC() xcd_barrier(xbar)
    unsigned char* ws = p.ws; const int G = gridDim.x, bx = blockIdx.x;
    const float* ropecs = (const float*)(ws + WS_ROPE);
    typedef pg8::bf16_t wb;
    p0_prologue(p, lds);
    GRID_SYNC();
    { pg8::Gemm g{(const wb*)(ws + WS_R0), (const wb*)(ws + W_IN), MP, N_IN, DM, nullptr, nullptr}; pg8::StaticOrder S; S.init(MP, N_IN, G, bx);
      pg8::EpiInProj E{(wb*)(ws + WS_R1), (wb*)(ws + WS_R2), (wb*)(ws + WS_R3), (wb*)(ws + WS_R4), (wb*)(ws + WS_CQ), (wb*)(ws + WS_CKV), (wb*)p.out, (wb*)(ws + WS_KPE), (float*)(ws + PART_Q), (float*)(ws + PART_KV), p.b_gate, ropecs};
      pg8::gemm_phase<pg8::EpiInProj, pg8::StaticOrder, true, true>(lds, g, S, E); }
    GRID_SYNC();
#ifdef SCAN_NAIVE
    scan_phase(p, lds);
#else
    scan_mfma_phase(p, lds);
#endif
    { pg8::Gemm g{(const wb*)(ws + WS_CKV), (const wb*)(ws + W_KVB), MP, 2048, 256, nullptr, nullptr}; pg8::StaticOrder S; S.init(MP, 2048, G, bx);
      pg8::EpiKV E{(wb*)(ws + WS_R0), (wb*)(ws + WS_R5), (const pg8::f32x4*)(ws + PART_KV)};
      pg8::gemm_phase<pg8::EpiKV, pg8::StaticOrder, true, true>(lds, g, S, E); }
    GRID_SYNC();
    { pg8::Gemm g{(const wb*)(ws + WS_CQ), (const wb*)(ws + W_QB), MR, 1536, 256, nullptr, nullptr}; pg8::StaticOrder S; S.init(MR, 1536, G, bx);
      pg8::EpiQ E{ws, 0.07216878364870322f * 1.4426950408889634f};
      pg8::gemm_phase<pg8::EpiQ, pg8::StaticOrder, true, true>(lds, g, S, E); }
    GRID_SYNC();
    attn_phase(p, lds);
    GRID_SYNC();
    { pg8::Gemm g{(const wb*)(ws + WS_R3), (const wb*)(ws + W_HGO), MR, DM, DM, (const wb*)(ws + WS_R4), (const wb*)(ws + W_MLAO)}; pg8::PairOrder S; S.so.init(MR, DM, G, bx);
      pg8::EpiMix E{(const wb*)p.out, (wb*)(ws + WS_R1), (wb*)(ws + WS_R2)};
      pg8::gemm_phase<pg8::EpiMix, pg8::PairOrder, true, true>(lds, g, S, E); }
    GRID_SYNC();
    { pg8::Gemm g{(const wb*)(ws + WS_R2), (const wb*)(ws + W_OUT), MR, DM, DM, nullptr, nullptr}; pg8::StaticOrder S; S.init(MR, DM, G, bx);
      pg8::EpiYSsq E{(wb*)(ws + WS_R0), (float*)(ws + PART_1)};
      pg8::gemm_phase<pg8::EpiYSsq, pg8::StaticOrder, true, true>(lds, g, S, E); }
    GRID_SYNC();
    rows1_phase(p);
    GRID_SYNC();
    { pg8::Gemm g{(const wb*)(ws + WS_R1), (const wb*)(ws + W_FIN), MR, 2 * FFH, DM, nullptr, nullptr}; pg8::StaticOrder S; S.init(MR, 2 * FFH, G, bx);
      pg8::EpiSwiglu E{(wb*)(ws + WS_R2), FFH};
      pg8::gemm_phase<pg8::EpiSwiglu, pg8::StaticOrder, true, true>(lds, g, S, E); }
    GRID_SYNC();
    { pg8::Gemm g{(const wb*)(ws + WS_R2), (const wb*)(ws + W_FOUT), MR, DM, FFH, nullptr, nullptr}; pg8::StaticOrder S; S.init(MR, DM, G, bx);
      pg8::EpiYSsq E{(wb*)(ws + WS_R0), (float*)(ws + PART_2)};
      pg8::gemm_phase<pg8::EpiYSsq, pg8::StaticOrder, true, true>(lds, g, S, E); }
    GRID_SYNC();
    rows2_phase(p);
}

extern "C" void kernel_launch(void* const* d_in, const int* in_sizes, int n_in, void* d_out, int out_size, void* d_ws, size_t ws_size, hipStream_t stream) {
    static int grid = 0;
    if (grid == 0) {
        if (n_in != 19 || out_size != MR * DM || ws_size < WS_END) { fprintf(stderr, "kernel_launch: unexpected shapes (n_in %d, out %d, ws %zu < %zu)\n", n_in, out_size, ws_size, (size_t)WS_END); grid = -1; return; }
        int dev = 0, cus = 0, per_cu = 0;
        hipGetDevice(&dev); hipDeviceGetAttribute(&cus, hipDeviceAttributeMultiprocessorCount, dev);
        if (hipFuncSetAttribute((const void*)fwd_megakernel, hipFuncAttributeMaxDynamicSharedMemorySize, LDS_BYTES) != hipSuccess) { fprintf(stderr, "kernel_launch: hipFuncSetAttribute failed\n"); grid = -1; return; }
        if (hipOccupancyMaxActiveBlocksPerMultiprocessor(&per_cu, (const void*)fwd_megakernel, NTHREADS, LDS_BYTES) != hipSuccess || per_cu < 1) { fprintf(stderr, "kernel_launch: occupancy query gave %d\n", per_cu); per_cu = 1; }
        (void)hipGetLastError();
        grid = cus * per_cu;
    }
    if (grid < 0) return;
    if (hipMemsetAsync((char*)d_ws + WS_BAR, 0, WS_BAR_BYTES, stream) != hipSuccess) { fprintf(stderr, "kernel_launch: hipMemsetAsync failed\n"); return; }
    Params p{};
    const float** f = (const float**)&p;
    for (int i = 0; i < 19; ++i) f[i] = (const float*)d_in[i];
    p.out = (float*)d_out; p.ws = (unsigned char*)d_ws;
    void* args[] = {&p};
    hipError_t e = hipLaunchCooperativeKernel((const void*)fwd_megakernel, dim3(grid), dim3(NTHREADS), args, LDS_BYTES, stream);
    if (e != hipSuccess) fprintf(stderr, "cooperative launch failed: %s (grid %d)\n", hipGetErrorString(e), grid);
}
```
